# Optimizing an MI355X kernel written in HIP

```python
import math
import jax, jax.numpy as jnp
from jax import lax
import numpy as np

D_MODEL = 1024
BATCH = 32
SEQ = 2048
DEPTH = 1

HEAD_DIM = 64
SB_HEADS = 8
MOBA_HEADS = 8
SB_WIDTH = SB_HEADS * HEAD_DIM
MOBA_WIDTH = MOBA_HEADS * HEAD_DIM
IN_WIDTH = 3 * SB_WIDTH + 3 * MOBA_WIDTH
SB_BLOCK = 128
MOBA_BLOCK = 256
MOBA_TOPK = 3
MOBA_Q_CHUNK = 16
NUM_BUCKETS = 32
MAX_EXACT = NUM_BUCKETS // 2
MAX_DISTANCE = 128
FFN_HIDDEN = int(math.ceil(8 * D_MODEL / 3 / 256) * 256)
PLE_DIM = 256
RMS_EPS = 1e-6
NEG = -1e30

kernel_name = "hybrid_stickbreak_moba_gated_block"


def rmsnorm(x, g):
    xf = x.astype(jnp.float32)
    y = xf * lax.rsqrt(jnp.mean(xf * xf, axis=-1, keepdims=True) + RMS_EPS)
    return (y * g.astype(jnp.float32)).astype(x.dtype)


def split_heads(t, n_heads):
    b, s, _ = t.shape
    return t.reshape(b, s, n_heads, HEAD_DIM).transpose(0, 2, 1, 3)


def merge_heads(t):
    b, h, s, d = t.shape
    return t.transpose(0, 2, 1, 3).reshape(b, s, h * d)


def t5_bucket(dist):
    n = jnp.maximum(dist, 0)
    nf = jnp.maximum(n, 1).astype(jnp.float32)
    large = MAX_EXACT + (jnp.log(nf / MAX_EXACT) / math.log(MAX_DISTANCE / MAX_EXACT)
                         * (NUM_BUCKETS - MAX_EXACT)).astype(jnp.int32)
    large = jnp.minimum(large, NUM_BUCKETS - 1)
    return jnp.where(n < MAX_EXACT, n, large)


def stick_breaking_attention(q, k, v):
    S = q.shape[2]
    scale = HEAD_DIM ** -0.5
    outs = []
    for i in range(S // SB_BLOCK):
        t0 = i * SB_BLOCK
        L = t0 + SB_BLOCK
        z = jnp.einsum('bhtd,bhsd->bhts', q[:, :, t0:L], k[:, :, :L]).astype(jnp.float32) * scale
        tpos = t0 + jnp.arange(SB_BLOCK)
        spos = jnp.arange(L)
        causal = spos[None, :] < tpos[:, None]
        log_fail = jnp.where(causal, jax.nn.log_sigmoid(-z), 0.0)
        suffix = lax.cumsum(log_fail, axis=3, reverse=True) - log_fail
        w = jnp.where(causal, jnp.exp(jax.nn.log_sigmoid(z) + suffix), 0.0)
        outs.append(jnp.einsum('bhts,bhsd->bhtd', w.astype(v.dtype), v[:, :, :L]))
    return jnp.concatenate(outs, axis=2)


_gather_blocks = jax.vmap(jax.vmap(lambda blk, idx: blk[idx]))


def moba_attention(q, k, v, rel_bias):
    B, H, S, dh = q.shape
    scale = HEAD_DIM ** -0.5
    nb = -(-S // MOBA_BLOCK)
    s_pad = nb * MOBA_BLOCK
    pad = ((0, 0), (0, 0), (0, s_pad - S), (0, 0))
    kb = jnp.pad(k, pad).reshape(B, H, nb, MOBA_BLOCK, dh)
    vb = jnp.pad(v, pad).reshape(B, H, nb, MOBA_BLOCK, dh)
    kbar = jnp.mean(kb.astype(jnp.float32), axis=3)
    gate = jnp.einsum('bhtd,bhnd->bhtn', q.astype(jnp.float32), kbar)
    cur_blk = jnp.arange(S) // MOBA_BLOCK
    past = jnp.arange(nb)[None, :] < cur_blk[:, None]
    gate = jnp.where(past, gate, -jnp.inf)
    k_sel = min(MOBA_TOPK, nb)
    _, sel = lax.top_k(gate, k_sel)
    sel_valid = sel < cur_blk[:, None]
    bias_t = rel_bias.T.astype(jnp.float32)
    h_idx = jnp.arange(H)[None, :, None, None, None]
    u = jnp.arange(MOBA_BLOCK)

    def chunk(ci):
        t0 = ci * MOBA_Q_CHUNK
        qc = lax.dynamic_slice_in_dim(q, t0, MOBA_Q_CHUNK, axis=2)
        selc = lax.dynamic_slice_in_dim(sel, t0, MOBA_Q_CHUNK, axis=2)
        validc = lax.dynamic_slice_in_dim(sel_valid, t0, MOBA_Q_CHUNK, axis=2)
        tpos = t0 + jnp.arange(MOBA_Q_CHUNK)
        c = t0 // MOBA_BLOCK
        own_k = lax.dynamic_index_in_dim(kb, c, axis=2, keepdims=False)
        own_v = lax.dynamic_index_in_dim(vb, c, axis=2, keepdims=False)
        spos_own = c * MOBA_BLOCK + u
        d_own = tpos[:, None] - spos_own[None, :]
        l_own = jnp.einsum('bhtd,bhsd->bhts', qc, own_k).astype(jnp.float32) * scale
        l_own = l_own + bias_t[:, t5_bucket(d_own)][None]
        l_own = jnp.where((d_own >= 0)[None, None], l_own, NEG)
        k_g = _gather_blocks(kb, selc)
        v_g = _gather_blocks(vb, selc)
        l_sel = jnp.einsum('bhtd,bhtjsd->bhtjs', qc, k_g).astype(jnp.float32) * scale
        d_sel = tpos[None, None, :, None, None] - (selc[..., None] * MOBA_BLOCK + u)
        l_sel = l_sel + bias_t[h_idx, t5_bucket(d_sel)]
        l_sel = jnp.where(validc[..., None], l_sel, NEG)
        kk = l_sel.shape[3]
        logits = jnp.concatenate([l_sel.reshape(B, H, MOBA_Q_CHUNK, kk * MOBA_BLOCK), l_own], axis=-1)
        probs = jax.nn.softmax(logits, axis=-1).astype(v.dtype)
        p_sel = probs[..., :kk * MOBA_BLOCK].reshape(B, H, MOBA_Q_CHUNK, kk, MOBA_BLOCK)
        p_own = probs[..., kk * MOBA_BLOCK:]
        return (jnp.einsum('bhtjs,bhtjsd->bhtd', p_sel, v_g)
                + jnp.einsum('bhts,bhsd->bhtd', p_own, own_v))

    outs = lax.map(chunk, jnp.arange(S // MOBA_Q_CHUNK))
    return outs.transpose(1, 2, 0, 3, 4).reshape(B, H, S, dh)


def setup_inputs(seed: int = 0) -> dict:
    key = jax.random.key(seed)
    ks = jax.random.split(key, 20)
    f32 = jnp.float32

    def w(k, shape, fan_in):
        return jax.random.normal(k, shape, f32) * (fan_in ** -0.5)

    def gain(k, shape):
        return 1.0 + 0.05 * jax.random.normal(k, shape, f32)

    return {
        "x": jax.random.normal(ks[0], (BATCH, SEQ, D_MODEL), f32),
        "p": jax.random.normal(ks[1], (DEPTH, BATCH, SEQ, PLE_DIM), f32),
        "ln_mix_g": gain(ks[2], (DEPTH, D_MODEL)),
        "w_in": w(ks[3], (DEPTH, D_MODEL, IN_WIDTH), D_MODEL),
        "w_gate": w(ks[4], (DEPTH, D_MODEL, 2 * D_MODEL), D_MODEL),
        "b_gate": 0.02 * jax.random.normal(ks[5], (DEPTH, 2 * D_MODEL), f32),
        "w_branch_sb": w(ks[6], (DEPTH, SB_WIDTH, D_MODEL), SB_WIDTH),
        "w_branch_moba": w(ks[7], (DEPTH, MOBA_WIDTH, D_MODEL), MOBA_WIDTH),
        "w_out": w(ks[8], (DEPTH, D_MODEL, D_MODEL), D_MODEL),
        "rel_bias": 0.5 * jax.random.normal(ks[9], (NUM_BUCKETS, MOBA_HEADS), f32),
        "ln_ffn_g": gain(ks[10], (DEPTH, D_MODEL)),
        "w_ffn_gate": w(ks[11], (DEPTH, D_MODEL, FFN_HIDDEN), D_MODEL),
        "w_ffn_up": w(ks[12], (DEPTH, D_MODEL, FFN_HIDDEN), D_MODEL),
        "w_ffn_down": w(ks[13], (DEPTH, FFN_HIDDEN, D_MODEL), FFN_HIDDEN),
        "ln_ple_g": gain(ks[14], (DEPTH, D_MODEL)),
        "w_ple_gate": w(ks[15], (DEPTH, D_MODEL, D_MODEL), D_MODEL),
        "w_ple_proj": w(ks[16], (DEPTH, PLE_DIM, D_MODEL), PLE_DIM),
        "final_g": gain(ks[17], (D_MODEL,)),
    }


def reference(x, p, ln_mix_g, w_in, w_gate, b_gate, w_branch_sb, w_branch_moba, w_out,
              rel_bias, ln_ffn_g, w_ffn_gate, w_ffn_up, w_ffn_down, ln_ple_g, w_ple_gate,
              w_ple_proj, final_g):
    for i in range(DEPTH):
        h = rmsnorm(x, ln_mix_g[i])
        proj = h @ w_in[i]
        q_sb, k_sb, v_sb, q_mb, k_mb, v_mb = jnp.split(
            proj, np.cumsum([SB_WIDTH] * 3 + [MOBA_WIDTH] * 2).tolist(), axis=-1)
        o_sb = stick_breaking_attention(split_heads(q_sb, SB_HEADS), split_heads(k_sb, SB_HEADS),
                                        split_heads(v_sb, SB_HEADS))
        o_mb = moba_attention(split_heads(q_mb, MOBA_HEADS), split_heads(k_mb, MOBA_HEADS),
                              split_heads(v_mb, MOBA_HEADS), rel_bias)
        y_sb = merge_heads(o_sb) @ w_branch_sb[i]
        y_mb = merge_heads(o_mb) @ w_branch_moba[i]
        g_sb, g_mb = jnp.split(jax.nn.sigmoid(h @ w_gate[i] + b_gate[i]), 2, axis=-1)
        x = x + (g_sb * y_sb + g_mb * y_mb) @ w_out[i]
        h2 = rmsnorm(x, ln_ffn_g[i])
        x = x + (jax.nn.silu(h2 @ w_ffn_gate[i]) * (h2 @ w_ffn_up[i])) @ w_ffn_down[i]
        g_ple = jax.nn.sigmoid(rmsnorm(x, ln_ple_g[i]) @ w_ple_gate[i])
        x = x + g_ple * (p[i] @ w_ple_proj[i])
    return rmsnorm(x, final_g)
```

```cpp
#include <hip/hip_runtime.h>
#include <hip/hip_cooperative_groups.h>
#include <cstdio>
#include <cstdint>
#include <cmath>
namespace cg = cooperative_groups;

#ifndef N_LAUNCHES
#define N_LAUNCHES 1
#endif
#ifndef DBG_NO_SB
#define DBG_NO_SB 0
#endif
#ifndef DBG_NO_MOBA
#define DBG_NO_MOBA 0
#endif

namespace pg8 {
#define PG8_LAS __attribute__((address_space(3)))
typedef unsigned short bf16_t;
typedef short bf16x8 __attribute__((ext_vector_type(8)));
typedef float f32x4 __attribute__((ext_vector_type(4)));
typedef unsigned u32x4 __attribute__((ext_vector_type(4)));
typedef unsigned u32x2 __attribute__((ext_vector_type(2)));
constexpr int BM = 256, BK = 64, HALF = 128, HTB = HALF * BK * 2  , STAGE_BYTES = 8 * HTB;

__host__ __device__ __forceinline__ int lds_byte(int r, int c) { const int st = (r >> 4) * 2 + (c >> 5), rr = r & 15, cc = c & 31, ob = rr * 64 + cc * 2; return st * 1024 + (ob ^ (((ob >> 9) & 1) << 5)); }
__host__ __device__ __forceinline__ void stage_rc(int b, int& R, int& C) { const int st = b / 1024, sb = b % 1024, swz = sb ^ (((sb >> 9) & 1) << 5); R = (st >> 1) * 16 + swz / 64; C = (st & 1) * 32 + (swz % 64) / 2; }
__host__ __device__ __forceinline__ int perm32(int rho) { const int n = rho >> 4, i = rho & 15; return 8 * (i >> 2) + 4 * n + (i & 3); }

struct Unit { int pm, pn, ka; };
struct Gemm { const bf16_t* A; const bf16_t* Bt; int lda, K; };

typedef float f32x2_t __attribute__((ext_vector_type(2))); typedef __bf16 bf16x2_t __attribute__((ext_vector_type(2)));
__device__ __forceinline__ unsigned cvt_pk_bf16(float lo, float hi) { f32x2_t v = {lo, hi}; bf16x2_t b = __builtin_convertvector(v, bf16x2_t); return __builtin_bit_cast(unsigned, b); }
__device__ __forceinline__ float bflo(unsigned w) { return __uint_as_float(w << 16); }
__device__ __forceinline__ float bfhi(unsigned w) { return __uint_as_float(w & 0xffff0000u); }
__device__ __forceinline__ float sigm(float x) { return __builtin_amdgcn_rcpf(1.f + __expf(-x)); }
__device__ __forceinline__ u32x4 pack8(f32x4 a, f32x4 b) { u32x4 w; w.x = cvt_pk_bf16(a[0], a[1]); w.y = cvt_pk_bf16(a[2], a[3]); w.z = cvt_pk_bf16(b[0], b[1]); w.w = cvt_pk_bf16(b[2], b[3]); return w; }

template <class Epi, class Sched, bool ALIGN_EPI = false, bool SP2 = false>
__device__ __forceinline__ void gemm_phase(PG8_LAS unsigned char* lds, const Gemm g, const Sched& S, const Epi& E) {
    int tid_ = threadIdx.x; asm volatile("" : "+v"(tid_));
    const int tid = tid_, wid = __builtin_amdgcn_readfirstlane(tid >> 6), lane = tid & 63, wr = wid >> 2, wc = wid & 3, fr = lane & 15, fq = lane >> 4;
    const int K = g.K, nt = K / BK;
    unsigned voffA[2], voffB[2];
#pragma unroll
    for (int i = 0; i < 2; ++i) { int R, C; stage_rc(tid * 16 + i * 8192, R, C); const int Rb = Epi::PERM ? ((R & ~31) + perm32(R & 31)) : R;
        voffA[i] = (unsigned)(R * g.lda + C) * 2u; voffB[i] = (unsigned)(Rb * K + C) * 2u; }
    const size_t kstep = (size_t)(BK * 2);
    const size_t hstepA = (size_t)HALF * g.lda * 2, hstepB = (size_t)HALF * K * 2;
    const size_t tstepA = 2 * hstepA, tstepB = 2 * hstepB;
    const unsigned ldsw = (unsigned)wid * 1024u;
    const int aoff = lds_byte(wr * 64 + fr, fq * 8), boff = lds_byte(wc * 32 + fr, fq * 8);
#define PG8_SA(b, h) (((b) * 2 + (h)) * HTB)
#define PG8_SB(b, h) ((4 + (b) * 2 + (h)) * HTB)
#define PG8_STAGE(bufoff, gbase, voff) do { _Pragma("unroll") for (int _i = 0; _i < 2; ++_i) \
        __builtin_amdgcn_global_load_lds((const unsigned*)((const char*)(gbase) + (voff)[_i]), (PG8_LAS unsigned*)(lds + (bufoff) + ldsw + _i * 8192), 16, 0, 0); } while (0)
#define PG8_LDA(dst, b, h) do { _Pragma("unroll") for (int m = 0; m < 4; ++m) _Pragma("unroll") for (int k = 0; k < 2; ++k) dst[m][k] = *(const PG8_LAS bf16x8*)(lds + PG8_SA(b, h) + aoff + m * 2048 + k * 1024); } while (0)
#define PG8_LDB(dst, b, h) do { _Pragma("unroll") for (int n = 0; n < 2; ++n) _Pragma("unroll") for (int k = 0; k < 2; ++k) dst[n][k] = *(const PG8_LAS bf16x8*)(lds + PG8_SB(b, h) + boff + n * 2048 + k * 1024); } while (0)
#define PG8_MMA(ai, bj, At, Bt) do { __builtin_amdgcn_s_setprio(1); _Pragma("unroll") for (int m = 0; m < 4; ++m) _Pragma("unroll") for (int n = 0; n < 2; ++n) _Pragma("unroll") for (int k = 0; k < 2; ++k) \
        acc[ai][bj][m][n] = __builtin_amdgcn_mfma_f32_16x16x32_bf16(Bt[n][k], At[m][k], acc[ai][bj][m][n], 0, 0, 0); __builtin_amdgcn_s_setprio(0); } while (0)
#define PG8_WAIT_V(n) asm volatile("s_waitcnt vmcnt(" #n ")" ::: "memory")
#define PG8_WAIT_L(n) asm volatile("s_waitcnt lgkmcnt(" #n ")" ::: "memory")
#define PG8_BAR __builtin_amdgcn_s_barrier()
#define PG8_SCHED __builtin_amdgcn_sched_barrier(0)
    Unit cur, nxt; int ui = 0;
    if (!S.next(0, cur)) return;
    f32x4 acc[2][2][4][2];
#pragma unroll
    for (int a = 0; a < 2; ++a)
#pragma unroll
        for (int b = 0; b < 2; ++b)
#pragma unroll
            for (int m = 0; m < 4; ++m)
#pragma unroll
                for (int n = 0; n < 2; ++n) acc[a][b][m][n] = (f32x4){0.f, 0.f, 0.f, 0.f};
    bf16x8 At[4][2], B0[2][2], B1[2][2];
    const char* cA = (const char*)g.A + (size_t)cur.pm * tstepA + (size_t)cur.ka * 2; const char* cB = (const char*)g.Bt + (size_t)cur.pn * tstepB;
    if constexpr (SP2) {
        PG8_STAGE(PG8_SB(0, 0), cB, voffB); PG8_STAGE(PG8_SB(0, 1), cB + hstepB, voffB); PG8_STAGE(PG8_SA(0, 0), cA, voffA); PG8_STAGE(PG8_SA(0, 1), cA + hstepA, voffA);
        if (wr == 1) PG8_BAR;
        PG8_WAIT_V(2); PG8_BAR;
        PG8_STAGE(PG8_SB(1, 0), cB + kstep, voffB); PG8_STAGE(PG8_SA(1, 0), cA + kstep, voffA); PG8_STAGE(PG8_SB(1, 1), cB + hstepB + kstep, voffB);
        PG8_WAIT_V(6); PG8_BAR;
    } else {
        PG8_STAGE(PG8_SB(0, 0), cB, voffB); PG8_STAGE(PG8_SA(0, 0), cA, voffA); PG8_STAGE(PG8_SB(0, 1), cB + hstepB, voffB); PG8_STAGE(PG8_SA(0, 1), cA + hstepA, voffA);
        if (wr == 1) PG8_BAR;
        PG8_WAIT_V(4); PG8_BAR;
        PG8_STAGE(PG8_SB(1, 0), cB + kstep, voffB); PG8_STAGE(PG8_SA(1, 0), cA + kstep, voffA); PG8_STAGE(PG8_SB(1, 1), cB + hstepB + kstep, voffB);
        PG8_WAIT_V(6); PG8_BAR;
    }
    for (;;) {
        const bool has_next = S.next(ui + 1, nxt);
        const char* nA = has_next ? (const char*)g.A + (size_t)nxt.pm * tstepA + (size_t)nxt.ka * 2 : cA; const char* nB = has_next ? (const char*)g.Bt + (size_t)nxt.pn * tstepB : cB;
        for (int t = 0; t < nt; t += 2) {
            const bool last = (t == nt - 2);
            const char* a1 = cA + (size_t)(t + 1) * kstep;
            const char* a2 = last ? nA : cA + (size_t)(t + 2) * kstep; const char* b2 = last ? nB : cB + (size_t)(t + 2) * kstep;
            const char* a3 = a2 + kstep; const char* b3 = b2 + kstep;
            if constexpr (SP2) {
            PG8_LDB(B0, 0, 0); PG8_LDB(B1, 0, 1); PG8_SCHED; PG8_LDA(At, 0, 0); PG8_STAGE(PG8_SA(1, 1), a1 + hstepA, voffA);
            PG8_WAIT_V(8); PG8_WAIT_L(0); PG8_BAR; PG8_MMA(0, 0, At, B0); PG8_MMA(0, 1, At, B1); PG8_BAR; PG8_SCHED;
            PG8_LDA(At, 0, 1); PG8_STAGE(PG8_SB(0, 0), b2, voffB); PG8_STAGE(PG8_SB(0, 1), b2 + hstepB, voffB); PG8_STAGE(PG8_SA(0, 0), a2, voffA);
            PG8_WAIT_V(8); PG8_WAIT_L(0); PG8_BAR; PG8_MMA(1, 0, At, B0); PG8_MMA(1, 1, At, B1); PG8_BAR; PG8_SCHED;
            PG8_LDB(B0, 1, 0); PG8_LDB(B1, 1, 1); PG8_SCHED; PG8_LDA(At, 1, 0); PG8_STAGE(PG8_SA(0, 1), a2 + hstepA, voffA);
            PG8_WAIT_V(8); PG8_WAIT_L(0); PG8_BAR; PG8_MMA(0, 0, At, B0); PG8_MMA(0, 1, At, B1); PG8_BAR; PG8_SCHED;
            PG8_LDA(At, 1, 1); PG8_STAGE(PG8_SB(1, 0), b3, voffB); PG8_STAGE(PG8_SB(1, 1), b3 + hstepB, voffB); PG8_STAGE(PG8_SA(1, 0), a3, voffA);
            PG8_WAIT_V(8); PG8_WAIT_L(0); PG8_BAR; PG8_MMA(1, 0, At, B0); PG8_MMA(1, 1, At, B1); PG8_BAR; PG8_SCHED;
            } else {
            PG8_LDB(B0, 0, 0); PG8_SCHED; PG8_LDA(At, 0, 0); PG8_STAGE(PG8_SA(1, 1), a1 + hstepA, voffA);
            PG8_WAIT_L(8); PG8_BAR; PG8_WAIT_L(0); PG8_MMA(0, 0, At, B0); PG8_BAR; PG8_SCHED;
            PG8_LDB(B1, 0, 1); PG8_STAGE(PG8_SB(0, 0), b2, voffB);
            PG8_BAR; PG8_WAIT_L(0); PG8_MMA(0, 1, At, B1); PG8_BAR;
            PG8_LDA(At, 0, 1); PG8_STAGE(PG8_SA(0, 0), a2, voffA);
            PG8_BAR; PG8_WAIT_L(0); PG8_MMA(1, 0, At, B0); PG8_BAR; PG8_SCHED;
            PG8_STAGE(PG8_SB(0, 1), b2 + hstepB, voffB);
            PG8_WAIT_V(6); PG8_BAR; PG8_MMA(1, 1, At, B1); PG8_BAR;
            PG8_LDB(B0, 1, 0); PG8_SCHED; PG8_LDA(At, 1, 0); PG8_STAGE(PG8_SA(0, 1), a2 + hstepA, voffA);
            PG8_WAIT_L(8); PG8_BAR; PG8_WAIT_L(0); PG8_MMA(0, 0, At, B0); PG8_BAR; PG8_SCHED;
            PG8_LDB(B1, 1, 1); PG8_STAGE(PG8_SB(1, 0), b3, voffB);
            PG8_BAR; PG8_WAIT_L(0); PG8_MMA(0, 1, At, B1); PG8_BAR;
            PG8_LDA(At, 1, 1); PG8_STAGE(PG8_SA(1, 0), a3, voffA);
            PG8_BAR; PG8_WAIT_L(0); PG8_MMA(1, 0, At, B0); PG8_BAR; PG8_SCHED;
            PG8_STAGE(PG8_SB(1, 1), b3 + hstepB, voffB);
            PG8_WAIT_V(6); PG8_BAR; PG8_MMA(1, 1, At, B1); PG8_BAR;
            }
        }
        if constexpr (ALIGN_EPI) { if (wr == 0) PG8_BAR; }
        const bool keep = E(acc, cur, wr, wc, fr, fq);
        if (!has_next) break;
        if (!keep) {
#pragma unroll
        for (int a = 0; a < 2; ++a)
#pragma unroll
            for (int b = 0; b < 2; ++b)
#pragma unroll
                for (int m = 0; m < 4; ++m)
#pragma unroll
                    for (int n = 0; n < 2; ++n) acc[a][b][m][n] = (f32x4){0.f, 0.f, 0.f, 0.f};
        }
        cur = nxt; cA = nA; cB = nB; ++ui;
        if constexpr (ALIGN_EPI) { if (wr == 1) PG8_BAR; }
    }
    PG8_WAIT_V(0);
    if constexpr (!ALIGN_EPI) { if (wr == 0) PG8_BAR; }
    PG8_BAR;
#undef PG8_SA
#undef PG8_SB
#undef PG8_STAGE
#undef PG8_LDA
#undef PG8_LDB
#undef PG8_MMA
#undef PG8_WAIT_V
#undef PG8_WAIT_L
#undef PG8_BAR
#undef PG8_SCHED
}
}

using pg8::bf16_t; using pg8::f32x4; using pg8::u32x4; using pg8::u32x2; using pg8::Unit; using pg8::cvt_pk_bf16; using pg8::bflo; using pg8::bfhi; using pg8::sigm; using pg8::pack8;
#define LAS __attribute__((address_space(3)))

constexpr int NB = 32, SEQ = 2048, DM = 1024, MTOK = NB * SEQ, NP = MTOK / 256;
constexpr int FFH = 2816, PLE = 256;
constexpr float EPS = 1e-6f, LOG2E = 1.4426950408889634f;

constexpr size_t MiB = 1u << 20;
constexpr size_t WS_RSTD0 = 0, WS_KPART = 1 * MiB;
constexpr size_t WS_W1T = 2 * MiB, WS_WVT = 10 * MiB, WS_W3T = 12 * MiB, WS_WOT = 14 * MiB, WS_WGUT = 16 * MiB, WS_WDT = 27 * MiB, WS_WPGT = 33 * MiB, WS_WPPT = 35 * MiB;
constexpr size_t WS_SSQ1 = 36 * MiB, WS_SSQ2 = 40 * MiB, WS_SSQ3 = 44 * MiB;
constexpr size_t WS_PB = 48 * MiB;
constexpr size_t WS_XB = 80 * MiB;
constexpr size_t WS_QK = 208 * MiB;
constexpr size_t WS_VT = 464 * MiB;
constexpr size_t WS_H = 208 * MiB;
constexpr size_t WS_GT = 592 * MiB;
constexpr size_t WS_A2 = 848 * MiB;
constexpr size_t WS_END = 976 * MiB;
static_assert(WS_H + (size_t)MTOK * FFH * 2 <= WS_GT && WS_VT + (size_t)MTOK * 512 * 2 * 2 <= WS_GT, "ws map");

constexpr int RING_BYTES = 131072, RS_OFF = RING_BYTES, LDS_BYTES = RING_BYTES + 4096;

struct PanelSched {
    int pm, n, mode;
    __device__ __forceinline__ bool next(int i, Unit& u) const {
        if (i >= n) return false;
        if (mode == 0) { u.pm = pm; u.pn = i; u.ka = 0; }
        else if (mode == 2) { u.pm = i; u.pn = pm; u.ka = 0; }
        else { const int pass = i & 1; u.pm = pm; u.pn = (i >> 1) + 4 * pass; u.ka = 512 * pass; }
        return true;
    }
};

struct Epi1 {
    static constexpr bool PERM = true;
    const float* rstd0; const float* bgate; bf16_t* QK; bf16_t* Gt; float* kpart;
    __device__ __forceinline__ bool operator()(f32x4 (&acc)[2][2][4][2], const Unit& u, int wr, int wc, int fr, int fq) const {
        const int rowl = wr * 64 + fr, row0 = u.pm * 256 + rowl, lc0 = wc * 32 + 8 * fq, pn = u.pn;
        float rs[2][4];
#pragma unroll
        for (int ai = 0; ai < 2; ++ai)
#pragma unroll
            for (int m = 0; m < 4; ++m) rs[ai][m] = rstd0[row0 + ai * 128 + m * 16];
        if (pn < 8) {
            const int cb = pn * 256 + lc0;
#pragma unroll
            for (int ai = 0; ai < 2; ++ai)
#pragma unroll
                for (int m = 0; m < 4; ++m) {
                    bf16_t* rowp = QK + (size_t)(row0 + ai * 128 + m * 16) * 2048 + cb; const float r = rs[ai][m];
#pragma unroll
                    for (int bj = 0; bj < 2; ++bj) *(u32x4*)(rowp + bj * 128) = pack8(acc[ai][bj][m][0] * r, acc[ai][bj][m][1] * r);
                }
            if (pn >= 6) {
#pragma unroll
                for (int bj = 0; bj < 2; ++bj)
#pragma unroll
                    for (int n = 0; n < 2; ++n)
#pragma unroll
                        for (int j = 0; j < 4; ++j) {
                            float s = 0.f;
#pragma unroll
                            for (int ai = 0; ai < 2; ++ai)
#pragma unroll
                                for (int m = 0; m < 4; ++m) s += acc[ai][bj][m][n][j] * rs[ai][m];
                            s += __shfl_xor(s, 1); s += __shfl_xor(s, 2); s += __shfl_xor(s, 4); s += __shfl_xor(s, 8);
                            if (fr == 0) kpart[(size_t)(u.pm * 2 + wr) * 512 + (pn & 1) * 256 + bj * 128 + lc0 + 4 * n + j] = s;
                        }
            }
        } else {
            const int gc = (pn - 8) * 256 + lc0;
            f32x4 bv[2][2];
#pragma unroll
            for (int bj = 0; bj < 2; ++bj)
#pragma unroll
                for (int n = 0; n < 2; ++n) bv[bj][n] = *(const f32x4*)(bgate + gc + bj * 128 + 4 * n);
#pragma unroll
            for (int ai = 0; ai < 2; ++ai)
#pragma unroll
                for (int m = 0; m < 4; ++m) {
                    bf16_t* rowp = Gt + (size_t)(row0 + ai * 128 + m * 16) * 2048 + gc; const float r = rs[ai][m];
#pragma unroll
                    for (int bj = 0; bj < 2; ++bj) {
                        f32x4 v0 = acc[ai][bj][m][0] * r + bv[bj][0], v1 = acc[ai][bj][m][1] * r + bv[bj][1];
#pragma unroll
                        for (int j = 0; j < 4; ++j) { v0[j] = sigm(v0[j]); v1[j] = sigm(v1[j]); }
                        *(u32x4*)(rowp + bj * 128) = pack8(v0, v1);
                    }
                }
        }
        return false;
    }
};

struct EpiVT {
    static constexpr bool PERM = true;
    const float* rstd0; bf16_t* VT;
    __device__ __forceinline__ bool operator()(f32x4 (&acc)[2][2][4][2], const Unit& u, int wr, int wc, int fr, int fq) const {
        const int b = u.pn >> 3, t0 = (u.pn & 7) * 256 + wc * 32 + 8 * fq;
        f32x4 rv[2][2];
#pragma unroll
        for (int bj = 0; bj < 2; ++bj)
#pragma unroll
            for (int n = 0; n < 2; ++n) rv[bj][n] = *(const f32x4*)(rstd0 + (size_t)b * SEQ + t0 + bj * 128 + 4 * n);
#pragma unroll
        for (int ai = 0; ai < 2; ++ai)
#pragma unroll
            for (int m = 0; m < 4; ++m) {
                const int vr = u.pm * 256 + ai * 128 + wr * 64 + m * 16 + fr;
                bf16_t* rowp = VT + ((size_t)(((vr >> 9) * 32 + b) * 512 + (vr & 511))) * 2048 + t0;
#pragma unroll
                for (int bj = 0; bj < 2; ++bj) *(u32x4*)(rowp + bj * 128) = pack8(acc[ai][bj][m][0] * rv[bj][0], acc[ai][bj][m][1] * rv[bj][1]);
            }
        return false;
    }
};

struct Epi3 {
    static constexpr bool PERM = true;
    const bf16_t* Gt; bf16_t* mix;
    __device__ __forceinline__ bool operator()(f32x4 (&acc)[2][2][4][2], const Unit& u, int wr, int wc, int fr, int fq) const {
        const int pass = u.pn >> 2, nc = (u.pn & 3) * 256 + wc * 32 + 8 * fq, row0 = u.pm * 256 + wr * 64 + fr;
#pragma unroll
        for (int ai = 0; ai < 2; ++ai)
#pragma unroll
            for (int m = 0; m < 4; ++m) {
                const size_t row = (size_t)(row0 + ai * 128 + m * 16); const bf16_t* gp = Gt + row * 2048 + nc + pass * 1024;
#pragma unroll
                for (int bj = 0; bj < 2; ++bj) {
                    const u32x4 gg = *(const u32x4*)(gp + bj * 128);
                    const f32x4 g0 = {bflo(gg.x), bfhi(gg.x), bflo(gg.y), bfhi(gg.y)}, g1 = {bflo(gg.z), bfhi(gg.z), bflo(gg.w), bfhi(gg.w)};
                    f32x4 v0 = acc[ai][bj][m][0] * g0, v1 = acc[ai][bj][m][1] * g1;
                    u32x4* mp = (u32x4*)(mix + row * 1024 + nc + bj * 128);
                    if (pass == 1) { const u32x4 t = *mp;
                        v0 += (f32x4){bflo(t.x), bfhi(t.x), bflo(t.y), bfhi(t.y)}; v1 += (f32x4){bflo(t.z), bfhi(t.z), bflo(t.w), bfhi(t.w)}; }
                    *mp = pack8(v0, v1);
                }
            }
        return false;
    }
};

template <int MODE> struct EpiRes {
    static constexpr bool PERM = false;
    const float* base; float* out; bf16_t* xb; float* ssq; const float* PP; const LAS float* rs;
    __device__ __forceinline__ bool operator()(f32x4 (&acc)[2][2][4][2], const Unit& u, int wr, int wc, int fr, int fq) const {
        const int rl = wr * 64 + fr, c0 = u.pn * 256 + wc * 32 + 4 * fq;
#pragma unroll
        for (int ai = 0; ai < 2; ++ai)
#pragma unroll
            for (int m = 0; m < 4; ++m) {
                const int rloc = ai * 128 + m * 16 + rl; const size_t row = (size_t)u.pm * 256 + rloc; float ss = 0.f; const float r = MODE == 1 ? rs[rloc] : 0.f;
#pragma unroll
                for (int bj = 0; bj < 2; ++bj)
#pragma unroll
                    for (int n = 0; n < 2; ++n) {
                        const size_t off = row * 1024 + c0 + bj * 128 + n * 16; const f32x4 bs = *(const f32x4*)(base + off); f32x4 v;
                        if (MODE == 0) v = bs + acc[ai][bj][m][n];
                        else { const f32x4 pp = *(const f32x4*)(PP + off); f32x4 a = acc[ai][bj][m][n] * r;
#pragma unroll
                            for (int j = 0; j < 4; ++j) a[j] = sigm(a[j]);
                            v = bs + a * pp; }
                        *(f32x4*)(out + off) = v; ss += (v[0] * v[0] + v[1] * v[1]) + (v[2] * v[2] + v[3] * v[3]);
                        if (xb) { u32x2 w; w.x = cvt_pk_bf16(v[0], v[1]); w.y = cvt_pk_bf16(v[2], v[3]); *(u32x2*)(xb + off) = w; }
                    }
                ss += __shfl_xor(ss, 16); ss += __shfl_xor(ss, 32);
                if (fq == 0) ssq[row * 16 + u.pn * 4 + wc] = ss;
            }
        return false;
    }
};

struct Epi5 {
    static constexpr bool PERM = true;
    bf16_t* H; const LAS float* rs;
    __device__ __forceinline__ bool operator()(f32x4 (&acc)[2][2][4][2], const Unit& u, int wr, int wc, int fr, int fq) const {
        const int rl = wr * 64 + fr, hc = u.pn * 128 + wc * 32 + 8 * fq;
#pragma unroll
        for (int ai = 0; ai < 2; ++ai)
#pragma unroll
            for (int m = 0; m < 4; ++m) {
                const int rloc = ai * 128 + m * 16 + rl; const size_t row = (size_t)u.pm * 256 + rloc; const float r = rs[rloc];
                f32x4 h[2];
#pragma unroll
                for (int n = 0; n < 2; ++n) { const f32x4 g = acc[ai][0][m][n] * r, up = acc[ai][1][m][n] * r;
#pragma unroll
                    for (int j = 0; j < 4; ++j) h[n][j] = g[j] * sigm(g[j]) * up[j]; }
                *(u32x4*)(H + row * FFH + hc) = pack8(h[0], h[1]);
            }
        return false;
    }
};

struct EpiF32 {
    static constexpr bool PERM = false;
    float* out;
    __device__ __forceinline__ bool operator()(f32x4 (&acc)[2][2][4][2], const Unit& u, int wr, int wc, int fr, int fq) const {
        const int rl = wr * 64 + fr, c0 = u.pn * 256 + wc * 32 + 4 * fq;
#pragma unroll
        for (int ai = 0; ai < 2; ++ai)
#pragma unroll
            for (int m = 0; m < 4; ++m) { const size_t row = (size_t)u.pm * 256 + ai * 128 + m * 16 + rl;
#pragma unroll
                for (int bj = 0; bj < 2; ++bj)
#pragma unroll
                    for (int n = 0; n < 2; ++n) *(f32x4*)(out + row * 1024 + c0 + bj * 128 + n * 16) = acc[ai][bj][m][n]; }
        return false;
    }
};

namespace att {
typedef short bf16x8 __attribute__((ext_vector_type(8)));
typedef float f32x16 __attribute__((ext_vector_type(16)));
#define MFMA32(a, b, c) __builtin_amdgcn_mfma_f32_32x32x16_bf16((a), (b), (c), 0, 0, 0)
__device__ __forceinline__ int swap23(int r) { return (r & 0x13) | ((r & 4) << 1) | ((r & 8) >> 1); }
__device__ __forceinline__ float bf2f(short b) { return __uint_as_float(((unsigned)(unsigned short)b) << 16); }
__device__ __forceinline__ bf16x8 pack8f(const float* p) {
    u32x4 w; w.x = cvt_pk_bf16(p[0], p[1]); w.y = cvt_pk_bf16(p[2], p[3]); w.z = cvt_pk_bf16(p[4], p[5]); w.w = cvt_pk_bf16(p[6], p[7]);
    return __builtin_bit_cast(bf16x8, w);
}
struct Frag { bf16x8 k[4]; bf16x8 v[2][2]; };
__device__ __forceinline__ void load_tile(Frag& f, const bf16_t* kp, const bf16_t* vp) {
#pragma unroll
    for (int s = 0; s < 4; ++s) f.k[s] = *(const bf16x8*)(kp + 16 * s);
#pragma unroll
    for (int dt = 0; dt < 2; ++dt)
#pragma unroll
        for (int g = 0; g < 2; ++g) f.v[dt][g] = *(const bf16x8*)(vp + (size_t)dt * 32 * 2048 + 16 * g);
}
__device__ __forceinline__ void store_o(bf16_t* op, const f32x16& o0, const f32x16& o1, float inv) {
    float t[8];
#pragma unroll
    for (int g = 0; g < 2; ++g) {
#pragma unroll
        for (int e = 0; e < 8; ++e) t[e] = o0[8 * g + e] * inv;
        *(bf16x8*)(op + 16 * g) = pack8f(t);
#pragma unroll
        for (int e = 0; e < 8; ++e) t[e] = o1[8 * g + e] * inv;
        *(bf16x8*)(op + 32 + 16 * g) = pack8f(t);
    }
}

__device__ __forceinline__ void moba_wave(int b, int h, int c, int sub, const bf16_t* QK, const bf16_t* VT, const float* kpart, bf16_t* O,
                                          const LAS float* lut, LAS float* kb, int lane) {
    const int ql = lane & 31, hi = lane >> 5;
    const int tq = c * 256 + sub * 32 + ql;
    const size_t qrow = (size_t)b * SEQ + tq;
    for (int j = 0; j < c; ++j) { const float* kp = kpart + (size_t)((b * 8 + j) * 2) * 512 + h * 64 + lane; kb[j * 64 + lane] = (kp[0] + kp[512]) * (1.f / 256.f); }
    asm volatile("s_waitcnt lgkmcnt(0)" ::: "memory");
    bf16x8 qf[4];
    { const bf16_t* qp = QK + qrow * 2048 + 1024 + h * 64 + 8 * hi;
#pragma unroll
      for (int s = 0; s < 4; ++s) qf[s] = *(const bf16x8*)(qp + 16 * s); }
    unsigned sel;
    if (c <= 3) sel = (1u << c) - 1u;
    else {
        float g[7];
#pragma unroll
        for (int j = 0; j < 7; ++j) {
            float a = -INFINITY;
            if (j < c) {
                a = 0.f;
#pragma unroll
                for (int s = 0; s < 4; ++s)
#pragma unroll
                    for (int e = 0; e < 8; ++e) a += bf2f(qf[s][e]) * kb[j * 64 + 16 * s + 8 * hi + e];
                a += __shfl_xor(a, 32);
            }
            g[j] = a;
        }
        sel = 0u;
#pragma unroll
        for (int k = 0; k < 3; ++k) {
            float best = -INFINITY; int bi = 0;
#pragma unroll
            for (int j = 0; j < 7; ++j) { const bool t = !((sel >> j) & 1u) && g[j] > best; best = t ? g[j] : best; bi = t ? j : bi; }
            sel |= 1u << bi;
        }
    }
    unsigned rem = 0u;
    for (int j = 0; j < c; ++j) if (__ballot((sel >> j) & 1u) != 0ull) rem |= 1u << j;
    rem = __builtin_amdgcn_readfirstlane(rem);

    const float c2 = 0.125f * LOG2E, bfar = lut[127];
    f32x16 o0, o1;
#pragma unroll
    for (int r = 0; r < 16; ++r) { o0[r] = 0.f; o1[r] = 0.f; }
    float m_run = -INFINITY, l_run = 0.f;
    const bf16_t* kbase = QK + (size_t)b * SEQ * 2048 + 1536 + h * 64 + 8 * hi + (size_t)swap23(ql) * 2048;
    const bf16_t* vbase = VT + ((size_t)((32 + b) * 8 + h) * 64 + swap23(ql)) * 2048 + 8 * hi;
    int tok = c * 256; bool in_own = true;
    Frag cur, nxt;
    load_tile(cur, kbase + (size_t)tok * 2048, vbase + tok);
    for (;;) {
        int tokn = tok; bool has_next = true;
        if (in_own && tok < c * 256 + sub * 32) tokn = tok + 32;
        else if (!in_own && (tok & 255) != 224) tokn = tok + 32;
        else if (rem) { const int j = __builtin_ctz(rem); rem &= rem - 1u; tokn = j * 256; }
        else has_next = false;
        if (has_next) load_tile(nxt, kbase + (size_t)tokn * 2048, vbase + tokn);
        {
            const int jb = tok >> 8; const bool own = (jb == c);
            f32x16 S;
#pragma unroll
            for (int r = 0; r < 16; ++r) S[r] = 0.f;
#pragma unroll
            for (int s = 0; s < 4; ++s) S = MFMA32(cur.k[s], qf[s], S);
            asm volatile("" :: "v"(cur.k[0]), "v"(cur.k[1]), "v"(cur.k[2]), "v"(cur.k[3]));
            const int dist0 = tq - tok - 8 * hi;
            const bool lanesel = own || ((sel >> jb) & 1u);
            float x[16];
            if (jb + 1 < c) {
#pragma unroll
                for (int r = 0; r < 16; ++r) x[r] = lanesel ? (S[r] * c2 + bfar) : -INFINITY;
            } else {
#pragma unroll
                for (int r = 0; r < 16; ++r) {
                    const int dist = dist0 - ((r & 7) + 16 * (r >> 3));
                    const int di = dist < 0 ? 0 : (dist > 127 ? 127 : dist);
                    const float v = S[r] * c2 + lut[di];
                    const bool valid = own ? (dist >= 0) : lanesel;
                    x[r] = valid ? v : -INFINITY;
                }
            }
            float mx = x[0];
#pragma unroll
            for (int r = 1; r < 16; ++r) mx = fmaxf(mx, x[r]);
            mx = fmaxf(mx, __shfl_xor(mx, 32));
            const float m_new = fmaxf(m_run, mx);
            const float alpha = __builtin_amdgcn_exp2f(m_run - m_new);
            float p[16]; float ls = 0.f;
#pragma unroll
            for (int r = 0; r < 16; ++r) { p[r] = __builtin_amdgcn_exp2f(x[r] - m_new); ls += p[r]; }
            l_run = l_run * alpha + ls; m_run = m_new;
#pragma unroll
            for (int r = 0; r < 16; ++r) { o0[r] *= alpha; o1[r] *= alpha; }
            const bf16x8 pb0 = pack8f(p), pb1 = pack8f(p + 8);
            o0 = MFMA32(cur.v[0][0], pb0, o0); o0 = MFMA32(cur.v[0][1], pb1, o0);
            o1 = MFMA32(cur.v[1][0], pb0, o1); o1 = MFMA32(cur.v[1][1], pb1, o1);
        }
        if (!has_next) break;
        if (in_own && tokn < tok) in_own = false;
        if (in_own && !(tok < c * 256 + sub * 32)) in_own = false;
        cur = nxt; tok = tokn;
    }
    const float l = l_run + __shfl_xor(l_run, 32);
    store_o(O + qrow * 1024 + 512 + h * 64 + 8 * hi, o0, o1, 1.f / l);
}

__device__ __forceinline__ void sb_wave(int b, int h, int qblk, int sub, const bf16_t* QK, const bf16_t* VT, bf16_t* O, int lane) {
    const int ql = lane & 31, hi = lane >> 5;
    const int tq = qblk * 256 + sub * 32 + ql;
    const size_t qrow = (size_t)b * SEQ + tq;
    bf16x8 qf[4];
    { const bf16_t* qp = QK + qrow * 2048 + h * 64 + 8 * hi;
#pragma unroll
      for (int s = 0; s < 4; ++s) qf[s] = *(const bf16x8*)(qp + 16 * s); }
    const bf16_t* kbase = QK + (size_t)b * SEQ * 2048 + 512 + h * 64 + 8 * hi + (size_t)swap23(ql) * 2048;
    const bf16_t* vbase = VT + ((size_t)(b * 8 + h) * 64 + swap23(ql)) * 2048 + 8 * hi;
    f32x16 o0, o1;
#pragma unroll
    for (int r = 0; r < 16; ++r) { o0[r] = 0.f; o1[r] = 0.f; }
    float carry = 0.f;
    const int tdiag = qblk * 256 + sub * 32;
    int tok = tdiag;
    Frag cur, nxt;
    load_tile(cur, kbase + (size_t)tok * 2048, vbase + tok);
    for (;;) {
        const bool has_next = tok > 0;
        if (has_next) load_tile(nxt, kbase + (size_t)(tok - 32) * 2048, vbase + (tok - 32));
        {
            f32x16 S;
#pragma unroll
            for (int r = 0; r < 16; ++r) S[r] = 0.f;
#pragma unroll
            for (int s = 0; s < 4; ++s) S = MFMA32(cur.k[s], qf[s], S);
            asm volatile("" :: "v"(cur.k[0]), "v"(cur.k[1]), "v"(cur.k[2]), "v"(cur.k[3]));
            const bool diag = (tok == tdiag);
            float lf[16], zl[16];
            float G0 = 0.f, G1 = 0.f;
#pragma unroll
            for (int r = 0; r < 16; ++r) {
                const int kl = (r & 7) + 8 * hi + 16 * (r >> 3);
                const float z = S[r] * 0.125f;
                const float e = __expf(-fabsf(z));
                float f = -(fmaxf(z, 0.f) + __logf(1.f + e));
                const bool causal = !diag || (kl < ql);
                zl[r] = causal ? (z + f) : -INFINITY;
                f = causal ? f : 0.f; lf[r] = f;
                if (r < 8) G0 += f; else G1 += f;
            }
            const float P0 = __shfl_xor(G0, 32), P1 = __shfl_xor(G1, 32);
            const float a0 = hi ? (P1 + G1) : ((P0 + G1) + P1), a1 = hi ? 0.f : P1;
            float w[16];
            float run = carry + a1;
#pragma unroll
            for (int e = 7; e >= 0; --e) { w[8 + e] = __expf(zl[8 + e] + run); run += lf[8 + e]; }
            run = carry + a0;
#pragma unroll
            for (int e = 7; e >= 0; --e) { w[e] = __expf(zl[e] + run); run += lf[e]; }
            carry += (G0 + G1) + (P0 + P1);
            const bf16x8 pb0 = pack8f(w), pb1 = pack8f(w + 8);
            o0 = MFMA32(cur.v[0][0], pb0, o0); o0 = MFMA32(cur.v[0][1], pb1, o0);
            o1 = MFMA32(cur.v[1][0], pb0, o1); o1 = MFMA32(cur.v[1][1], pb1, o1);
        }
        if (!has_next) break;
        if (__ballot(carry > -104.f) == 0ull) break;
        cur = nxt; tok -= 32;
    }
    store_o(O + qrow * 1024 + h * 64 + 8 * hi, o0, o1, 1.f);
}
}

__device__ __forceinline__ float wave_sum(float v) {
#pragma unroll
    for (int o = 1; o < 64; o <<= 1) v += __shfl_xor(v, o);
    return v;
}
__device__ __forceinline__ void p0_transpose_item(const float* W, int K, int N, const float* gk, bf16_t* WT, int k0, int n0, int dst_row0, LAS float* scr, int lane) {
#pragma unroll 8
    for (int i = 0; i < 32; ++i) { const int kk = 2 * i + (lane >> 5); float w = W[(size_t)(k0 + kk) * N + n0 + (lane & 31)]; if (gk) w *= gk[k0 + kk]; scr[kk * 33 + (lane & 31)] = w; }
    asm volatile("s_waitcnt lgkmcnt(0)" ::: "memory");
    const int c = lane & 7;
#pragma unroll
    for (int j = 0; j < 4; ++j) { const int n = (lane >> 3) + 8 * j; const LAS float* s = scr + (8 * c) * 33 + n;
        u32x4 o; o.x = cvt_pk_bf16(s[0 * 33], s[1 * 33]); o.y = cvt_pk_bf16(s[2 * 33], s[3 * 33]); o.z = cvt_pk_bf16(s[4 * 33], s[5 * 33]); o.w = cvt_pk_bf16(s[6 * 33], s[7 * 33]);
        *(u32x4*)(WT + (size_t)(dst_row0 + n) * K + k0 + 8 * c) = o; }
    asm volatile("s_waitcnt lgkmcnt(0)" ::: "memory");
}

struct Args { const float* in[18]; float* out; unsigned char* ws; };

__device__ __forceinline__ void chain_fence() { __builtin_amdgcn_fence(__ATOMIC_ACQUIRE, "agent"); }
__device__ __forceinline__ void compute_rs(const float* ssq, int pm, LAS float* rs, int tid) {
    if (tid < 256) { const f32x4* p = (const f32x4*)(ssq + (size_t)(pm * 256 + tid) * 16); const f32x4 a = p[0], b = p[1], c = p[2], d = p[3];
        const float s = (((a[0] + a[1]) + (a[2] + a[3])) + ((b[0] + b[1]) + (b[2] + b[3]))) + (((c[0] + c[1]) + (c[2] + c[3])) + ((d[0] + d[1]) + (d[2] + d[3])));
        rs[tid] = rsqrtf(s * (1.f / DM) + EPS); }
    __syncthreads();
}

template <int PLO, int PHI>
__global__ void __launch_bounds__(512, 2) fwd_megakernel(Args args) {
    extern __shared__ __attribute__((aligned(16))) unsigned char lds_raw[];
    LAS unsigned char* lds = (LAS unsigned char*)lds_raw;
    cg::grid_group grid = cg::this_grid();
    const int tid = threadIdx.x, lane = tid & 63, wave = __builtin_amdgcn_readfirstlane(tid >> 6);
    const int G = gridDim.x, bx = blockIdx.x;
    unsigned char* ws = args.ws;
    const float* x = args.in[0]; float* out = args.out;
    float* rstd0 = (float*)(ws + WS_RSTD0); float* kpart = (float*)(ws + WS_KPART);
    bf16_t* W1t = (bf16_t*)(ws + WS_W1T); bf16_t* Wvt = (bf16_t*)(ws + WS_WVT); bf16_t* W3t = (bf16_t*)(ws + WS_W3T); bf16_t* Wot = (bf16_t*)(ws + WS_WOT); bf16_t* Wgut = (bf16_t*)(ws + WS_WGUT);
    bf16_t* Wdt = (bf16_t*)(ws + WS_WDT); bf16_t* Wpgt = (bf16_t*)(ws + WS_WPGT); bf16_t* Wppt = (bf16_t*)(ws + WS_WPPT);
    float* ssq1 = (float*)(ws + WS_SSQ1); float* ssq2 = (float*)(ws + WS_SSQ2); float* ssq3 = (float*)(ws + WS_SSQ3);
    bf16_t* PB = (bf16_t*)(ws + WS_PB); bf16_t* XB = (bf16_t*)(ws + WS_XB); bf16_t* QK = (bf16_t*)(ws + WS_QK); bf16_t* VT = (bf16_t*)(ws + WS_VT);
    bf16_t* HB = (bf16_t*)(ws + WS_H); bf16_t* Gt = (bf16_t*)(ws + WS_GT); float* PP = (float*)(ws + WS_GT); bf16_t* A2 = (bf16_t*)(ws + WS_A2);
    bf16_t* MIX = XB; bf16_t* XB2 = XB; bf16_t* XB1 = A2;
    LAS float* rs = (LAS float*)(lds + RS_OFF);

#define PH_IN(k) (PLO <= (k) && (k) < PHI)
    if constexpr (PH_IN(0)) {
        LAS float* scr = (LAS float*)(lds + wave * 16384);
        const int gw = bx * 8 + wave, NGW = G * 8;
        constexpr int I1 = 16 * 96, I2 = 16 * 64, I3 = 8 * 32, I5 = 16 * 32, I6 = 16 * 88, I8 = 44 * 32, I10 = 4 * 32;
        constexpr int NITEMS = I1 + I2 + 2 * I3 + I5 + 2 * I6 + I8 + I5 + I10;
        for (int it = gw; it < NITEMS; it += NGW) {
            int r = it;
            if (r < I1) { const int kb = r / 96, nb = r % 96, n0 = 32 * nb, grp = n0 >> 9, o = n0 & 511;
                bf16_t* dW = (grp == 2 || grp == 5) ? Wvt : W1t; const int dr = (grp == 2 ? 0 : grp == 5 ? 512 : grp == 0 ? 0 : grp == 1 ? 512 : grp == 3 ? 1024 : 1536) + o;
                p0_transpose_item(args.in[3], 1024, 3072, args.in[2], dW, 64 * kb, n0, dr, scr, lane); continue; } r -= I1;
            if (r < I2) { const int kb = r / 64, nb = r % 64; p0_transpose_item(args.in[4], 1024, 2048, args.in[2], W1t, 64 * kb, 32 * nb, 2048 + 32 * nb, scr, lane); continue; } r -= I2;
            if (r < I3) { const int kb = r / 32, nb = r % 32; p0_transpose_item(args.in[6], 512, 1024, nullptr, W3t, 64 * kb, 32 * nb, 32 * nb, scr, lane); continue; } r -= I3;
            if (r < I3) { const int kb = r / 32, nb = r % 32; p0_transpose_item(args.in[7], 512, 1024, nullptr, W3t, 64 * kb, 32 * nb, 1024 + 32 * nb, scr, lane); continue; } r -= I3;
            if (r < I5) { const int kb = r / 32, nb = r % 32; p0_transpose_item(args.in[8], 1024, 1024, nullptr, Wot, 64 * kb, 32 * nb, 32 * nb, scr, lane); continue; } r -= I5;
            if (r < I6) { const int kb = r / 88, nb = r % 88, n0 = 32 * nb; p0_transpose_item(args.in[11], 1024, FFH, args.in[10], Wgut, 64 * kb, n0, 256 * (n0 >> 7) + (n0 & 127), scr, lane); continue; } r -= I6;
            if (r < I6) { const int kb = r / 88, nb = r % 88, n0 = 32 * nb; p0_transpose_item(args.in[12], 1024, FFH, args.in[10], Wgut, 64 * kb, n0, 256 * (n0 >> 7) + 128 + (n0 & 127), scr, lane); continue; } r -= I6;
            if (r < I8) { const int kb = r / 32, nb = r % 32; p0_transpose_item(args.in[13], FFH, 1024, nullptr, Wdt, 64 * kb, 32 * nb, 32 * nb, scr, lane); continue; } r -= I8;
            if (r < I5) { const int kb = r / 32, nb = r % 32; p0_transpose_item(args.in[15], 1024, 1024, args.in[14], Wpgt, 64 * kb, 32 * nb, 32 * nb, scr, lane); continue; } r -= I5;
            { const int kb = r / 32, nb = r % 32; p0_transpose_item(args.in[16], PLE, 1024, nullptr, Wppt, 64 * kb, 32 * nb, 32 * nb, scr, lane); }
        }
        for (int m0 = gw * 32; m0 < MTOK; m0 += NGW * 32)
        for (int m = m0; m < m0 + 32; ++m) {
            const f32x4* xr = (const f32x4*)(x + (size_t)m * DM) + lane; f32x4 v[4]; float s = 0.f;
#pragma unroll
            for (int j = 0; j < 4; ++j) { v[j] = xr[64 * j]; s += (v[j][0] * v[j][0] + v[j][1] * v[j][1]) + (v[j][2] * v[j][2] + v[j][3] * v[j][3]); }
            s = wave_sum(s);
            if (lane == 0) rstd0[m] = rsqrtf(s * (1.f / DM) + EPS);
            u32x2* o8 = (u32x2*)(XB + (size_t)m * DM) + lane;
#pragma unroll
            for (int j = 0; j < 4; ++j) { u32x2 w; w.x = cvt_pk_bf16(v[j][0], v[j][1]); w.y = cvt_pk_bf16(v[j][2], v[j][3]); o8[64 * j] = w; }
        }
        const float* p = args.in[1];
        for (size_t i = (size_t)bx * 512 + tid; i < (size_t)MTOK * PLE / 8; i += (size_t)G * 512) {
            const f32x4 a = *(const f32x4*)(p + i * 8), b = *(const f32x4*)(p + i * 8 + 4);
            *(u32x4*)(PB + i * 8) = pack8(a, b);
        }
    }
    if constexpr (PH_IN(0) && PH_IN(1)) {
    asm volatile("s_waitcnt vmcnt(0) lgkmcnt(0)" ::: "memory");
    grid.sync();
    __builtin_amdgcn_fence(__ATOMIC_ACQUIRE, "agent");
    }

    if constexpr (PH_IN(1)) if (bx < NP) { const int pm = bx;
        { pg8::Gemm g{XB, W1t, 1024, 1024}; PanelSched S{pm, 16, 0};
          Epi1 E{rstd0, args.in[5], QK, Gt, kpart};
          pg8::gemm_phase<Epi1, PanelSched, true, true>(lds, g, S, E); }
        { pg8::Gemm g{Wvt, XB, 1024, 1024}; PanelSched S{pm, 4, 2};
          EpiVT E{rstd0, VT};
          pg8::gemm_phase<EpiVT, PanelSched, true, true>(lds, g, S, E); }
    }
    if constexpr (PH_IN(1) && PH_IN(2)) {
    asm volatile("s_waitcnt vmcnt(0) lgkmcnt(0)" ::: "memory");
    grid.sync();
    __builtin_amdgcn_fence(__ATOMIC_ACQUIRE, "agent");
    }

    if constexpr (PH_IN(2)) {
        LAS float* lut = (LAS float*)lds;
        LAS float* kb = (LAS float*)(lds + 4096 + wave * 2048);
        const float* rel_bias = args.in[9];
        for (int i = tid; i < 1024; i += 512) { const int hh = i >> 7, d = i & 127;
            int bk = d; if (d >= 16) { bk = 16 + (int)(logf((float)d / 16.f) / logf(8.f) * 16.f); bk = bk > 31 ? 31 : bk; }
            lut[i] = rel_bias[bk * 8 + hh] * LOG2E; }
        __syncthreads();
        int ui = 0;
        for (int u = bx; u < 4096; u += G, ++ui) {
            const int sub = (wave + ui) & 7;
            if (u < 2048) { const int c = 7 - (u >> 8), bh = u & 255;
#if !DBG_NO_MOBA
                att::moba_wave(bh >> 3, bh & 7, c, sub, QK, VT, kpart, A2, lut + (bh & 7) * 128, kb, lane);
#else
                { const size_t qrow = (size_t)(bh >> 3) * SEQ + c * 256 + sub * 32 + (lane & 31); u32x4 z = {0u, 0u, 0u, 0u};
                  *(u32x4*)(A2 + qrow * 1024 + 512 + (bh & 7) * 64 + 8 * (lane >> 5)) = z; *(u32x4*)(A2 + qrow * 1024 + 512 + (bh & 7) * 64 + 8 * (lane >> 5) + 16) = z;
                  *(u32x4*)(A2 + qrow * 1024 + 512 + (bh & 7) * 64 + 8 * (lane >> 5) + 32) = z; *(u32x4*)(A2 + qrow * 1024 + 512 + (bh & 7) * 64 + 8 * (lane >> 5) + 48) = z; }
#endif
            } else { const int v = u - 2048, qblk = 7 - (v >> 8), bh = v & 255;
#if !DBG_NO_SB
                att::sb_wave(bh >> 3, bh & 7, qblk, sub, QK, VT, A2, lane);
#else
                { const size_t qrow = (size_t)(bh >> 3) * SEQ + qblk * 256 + sub * 32 + (lane & 31); u32x4 z = {0u, 0u, 0u, 0u};
                  *(u32x4*)(A2 + qrow * 1024 + (bh & 7) * 64 + 8 * (lane >> 5)) = z; *(u32x4*)(A2 + qrow * 1024 + (bh & 7) * 64 + 8 * (lane >> 5) + 16) = z;
                  *(u32x4*)(A2 + qrow * 1024 + (bh & 7) * 64 + 8 * (lane >> 5) + 32) = z; *(u32x4*)(A2 + qrow * 1024 + (bh & 7) * 64 + 8 * (lane >> 5) + 48) = z; }
#endif
            }
        }
    }
    if constexpr (PH_IN(2) && PH_IN(3)) {
    asm volatile("s_waitcnt vmcnt(0) lgkmcnt(0)" ::: "memory");
    grid.sync();
    __builtin_amdgcn_fence(__ATOMIC_ACQUIRE, "agent");
    }

    if constexpr (PH_IN(3)) if (bx < NP) { const int pm = bx;
        {
            pg8::Gemm g{A2, W3t, 1024, 512}; PanelSched S{pm, 8, 1}; Epi3 E{Gt, MIX};
            pg8::gemm_phase<Epi3, PanelSched, true, true>(lds, g, S, E); chain_fence();
        }
        {
            pg8::Gemm g{MIX, Wot, 1024, 1024}; PanelSched S{pm, 4, 0}; EpiRes<0> E{x, out, XB1, ssq1, nullptr, rs};
            pg8::gemm_phase<EpiRes<0>, PanelSched, true, true>(lds, g, S, E); chain_fence();
        }
        compute_rs(ssq1, pm, rs, tid);
        {
            pg8::Gemm g{XB1, Wgut, 1024, 1024}; PanelSched S{pm, 22, 0}; Epi5 E{HB, rs};
            pg8::gemm_phase<Epi5, PanelSched, true, true>(lds, g, S, E); chain_fence();
        }
        {
            pg8::Gemm g{HB, Wdt, FFH, FFH}; PanelSched S{pm, 4, 0}; EpiRes<0> E{out, out, XB2, ssq2, nullptr, rs};
            pg8::gemm_phase<EpiRes<0>, PanelSched, true, true>(lds, g, S, E); chain_fence();
        }
        {
            pg8::Gemm g{PB, Wppt, PLE, PLE}; PanelSched S{pm, 4, 0}; EpiF32 E{PP};
            pg8::gemm_phase<EpiF32, PanelSched, true, true>(lds, g, S, E); chain_fence();
        }
        compute_rs(ssq2, pm, rs, tid);
        {
            pg8::Gemm g{XB2, Wpgt, 1024, 1024}; PanelSched S{pm, 4, 0}; EpiRes<1> E{out, out, nullptr, ssq3, PP, rs};
            pg8::gemm_phase<EpiRes<1>, PanelSched, true, true>(lds, g, S, E); chain_fence();
        }
        compute_rs(ssq3, pm, rs, tid);
        {
            const f32x4* fg = (const f32x4*)args.in[17] + lane;
            for (int r = wave; r < 256; r += 8) {
                f32x4* pr = (f32x4*)(out + (size_t)(pm * 256 + r) * DM) + lane; const float s = rs[r];
#pragma unroll
                for (int j = 0; j < 4; ++j) pr[64 * j] = pr[64 * j] * s * fg[64 * j];
            }
        }
        __syncthreads();
    }
}

extern "C" void kernel_launch(void* const* d_in, const int* in_sizes, int n_in, void* d_out, int out_size, void* d_ws, size_t ws_size, hipStream_t stream) {
    static int grid = 0;
    if (grid == 0) {
        if (n_in != 18 || out_size != MTOK * DM || ws_size < WS_END) { fprintf(stderr, "kernel_launch: unexpected problem shape (n_in %d, out %d, ws %zu)\n", n_in, out_size, ws_size); grid = -1; return; }
        int dev = 0, cus = 0, per_cu = 0;
        hipGetDevice(&dev); hipDeviceGetAttribute(&cus, hipDeviceAttributeMultiprocessorCount, dev);
        if (hipFuncSetAttribute((const void*)fwd_megakernel<0, 4>, hipFuncAttributeMaxDynamicSharedMemorySize, LDS_BYTES) != hipSuccess) fprintf(stderr, "kernel_launch: hipFuncSetAttribute failed\n");
        if (hipOccupancyMaxActiveBlocksPerMultiprocessor(&per_cu, (const void*)fwd_megakernel<0, 4>, 512, LDS_BYTES) != hipSuccess || per_cu < 1) { fprintf(stderr, "kernel_launch: occupancy query says %d\n", per_cu); per_cu = 1; }
        (void)hipGetLastError();
        if (cus * per_cu < NP) { fprintf(stderr, "kernel_launch: needs %d co-resident workgroups, device holds %d\n", NP, cus * per_cu); }
        grid = NP;
    }
    if (grid < 0) return;
    Args a{};
    for (int i = 0; i < 18; ++i) a.in[i] = (const float*)d_in[i];
    a.out = (float*)d_out; a.ws = (unsigned char*)d_ws;
    hipError_t e = hipSuccess;
#if N_LAUNCHES == 1
    void* kargs[] = {&a};
    e = hipLaunchCooperativeKernel((const void*)fwd_megakernel<0, 4>, dim3(grid), dim3(512), kargs, LDS_BYTES, stream);
#else
    hipFuncSetAttribute((const void*)fwd_megakernel<0, 1>, hipFuncAttributeMaxDynamicSharedMemorySize, LDS_BYTES); hipFuncSetAttribute((const void*)fwd_megakernel<1, 2>, hipFuncAttributeMaxDynamicSharedMemorySize, LDS_BYTES);
    hipFuncSetAttribute((const void*)fwd_megakernel<2, 3>, hipFuncAttributeMaxDynamicSharedMemorySize, LDS_BYTES); hipFuncSetAttribute((const void*)fwd_megakernel<3, 4>, hipFuncAttributeMaxDynamicSharedMemorySize, LDS_BYTES);
    hipLaunchKernelGGL((fwd_megakernel<0, 1>), dim3(grid), dim3(512), LDS_BYTES, stream, a); hipLaunchKernelGGL((fwd_megakernel<1, 2>), dim3(grid), dim3(512), LDS_BYTES, stream, a);
    hipLaunchKernelGGL((fwd_megakernel<2, 3>), dim3(grid), dim3(512), LDS_BYTES, stream, a); hipLaunchKernelGGL((fwd_megakernel<3, 4>), dim3(grid), dim3(512), LDS_BYTES, stream, a);
    e = hipPeekAtLastError();
#endif
    if (e != hipSuccess) fprintf(stderr, "kernel_launch: cooperative launch failed: %s (grid %d)\n", hipGetErrorString(e), grid);
}
```

```cpp
#include <hip/hip_runtime.h>
#include <hip/hip_cooperative_groups.h>
#include <cstdio>
#include <cstdint>
#include <cmath>
namespace cg = cooperative_groups;

#ifndef N_LAUNCHES
#define N_LAUNCHES 1
#endif
#ifndef REP_P0
#define REP_P0 1
#endif
#ifndef REP_P1
#define REP_P1 1
#endif
#ifndef REP_P2
#define REP_P2 1
#endif
#ifndef REP_P5
#define REP_P5 1
#endif
#ifndef PROBE_T
#define PROBE_T 0
#endif
#ifndef DBG_NO_SB
#define DBG_NO_SB 0
#endif
#ifndef DBG_NO_MOBA
#define DBG_NO_MOBA 0
#endif

namespace pg8 {
#define PG8_LAS __attribute__((address_space(3)))
typedef unsigned short bf16_t;
typedef short bf16x8 __attribute__((ext_vector_type(8)));
typedef float f32x4 __attribute__((ext_vector_type(4)));
typedef unsigned u32x4 __attribute__((ext_vector_type(4)));
typedef unsigned u32x2 __attribute__((ext_vector_type(2)));
constexpr int BM = 256, BK = 64, HALF = 128, HTB = HALF * BK * 2  , STAGE_BYTES = 8 * HTB;

__host__ __device__ __forceinline__ int lds_byte(int r, int c) { const int st = (r >> 4) * 2 + (c >> 5), rr = r & 15, cc = c & 31, ob = rr * 64 + cc * 2; return st * 1024 + (ob ^ (((ob >> 9) & 1) << 5)); }
__host__ __device__ __forceinline__ void stage_rc(int b, int& R, int& C) { const int st = b / 1024, sb = b % 1024, swz = sb ^ (((sb >> 9) & 1) << 5); R = (st >> 1) * 16 + swz / 64; C = (st & 1) * 32 + (swz % 64) / 2; }
__host__ __device__ __forceinline__ int perm32(int rho) { const int n = rho >> 4, i = rho & 15; return 8 * (i >> 2) + 4 * n + (i & 3); }

struct Unit { int pm, pn, ka; };
struct Gemm { const bf16_t* A; const bf16_t* Bt; int lda, K; };

typedef float f32x2_t __attribute__((ext_vector_type(2))); typedef __bf16 bf16x2_t __attribute__((ext_vector_type(2)));
__device__ __forceinline__ unsigned cvt_pk_bf16(float lo, float hi) { f32x2_t v = {lo, hi}; bf16x2_t b = __builtin_convertvector(v, bf16x2_t); return __builtin_bit_cast(unsigned, b); }
__device__ __forceinline__ float bflo(unsigned w) { return __uint_as_float(w << 16); }
__device__ __forceinline__ float bfhi(unsigned w) { return __uint_as_float(w & 0xffff0000u); }
__device__ __forceinline__ float sigm(float x) { return __builtin_amdgcn_rcpf(1.f + __expf(-x)); }
__device__ __forceinline__ u32x4 pack8(f32x4 a, f32x4 b) { u32x4 w; w.x = cvt_pk_bf16(a[0], a[1]); w.y = cvt_pk_bf16(a[2], a[3]); w.z = cvt_pk_bf16(b[0], b[1]); w.w = cvt_pk_bf16(b[2], b[3]); return w; }

template <class Epi, class Sched, bool ALIGN_EPI = false, bool SP2 = false>
__device__ __forceinline__ void gemm_phase(PG8_LAS unsigned char* lds, const Gemm g, const Sched& S, const Epi& E, const int wave_s) {
    int tid_; asm volatile("v_mbcnt_lo_u32_b32 %0, -1, 0\n\tv_mbcnt_hi_u32_b32 %0, -1, %0" : "=v"(tid_)); tid_ += 64 * wave_s;
    const int tid = tid_, wid = __builtin_amdgcn_readfirstlane(tid >> 6), lane = tid & 63, wr = wid >> 2, wc = wid & 3, fr = lane & 15, fq = lane >> 4;
    const int K = g.K, nt = K / BK;
    unsigned voffA[2], voffB[2];
#pragma unroll
    for (int i = 0; i < 2; ++i) { int R, C; stage_rc(tid * 16 + i * 8192, R, C); const int Rb = Epi::PERM ? ((R & ~31) + perm32(R & 31)) : R;
        voffA[i] = (unsigned)(R * g.lda + C) * 2u; voffB[i] = (unsigned)(Rb * K + C) * 2u; }
    const size_t kstep = (size_t)(BK * 2);
    const size_t hstepA = (size_t)HALF * g.lda * 2, hstepB = (size_t)HALF * K * 2;
    const size_t tstepA = 2 * hstepA, tstepB = 2 * hstepB;
    const unsigned ldsw = (unsigned)wid * 1024u;
    const int aoff = lds_byte(wr * 64 + fr, fq * 8), boff = lds_byte(wc * 32 + fr, fq * 8);
#define PG8_SA(b, h) (((b) * 2 + (h)) * HTB)
#define PG8_SB(b, h) ((4 + (b) * 2 + (h)) * HTB)
#define PG8_STAGE(bufoff, gbase, voff) do { _Pragma("unroll") for (int _i = 0; _i < 2; ++_i) \
        __builtin_amdgcn_global_load_lds((const unsigned*)((const char*)(gbase) + (voff)[_i]), (PG8_LAS unsigned*)(lds + (bufoff) + ldsw + _i * 8192), 16, 0, 0); } while (0)
#define PG8_LDA(dst, b, h) do { _Pragma("unroll") for (int m = 0; m < 4; ++m) _Pragma("unroll") for (int k = 0; k < 2; ++k) dst[m][k] = *(const PG8_LAS bf16x8*)(lds + PG8_SA(b, h) + aoff + m * 2048 + k * 1024); } while (0)
#define PG8_LDB(dst, b, h) do { _Pragma("unroll") for (int n = 0; n < 2; ++n) _Pragma("unroll") for (int k = 0; k < 2; ++k) dst[n][k] = *(const PG8_LAS bf16x8*)(lds + PG8_SB(b, h) + boff + n * 2048 + k * 1024); } while (0)
#define PG8_MMA(ai, bj, At, Bt) do { __builtin_amdgcn_s_setprio(1); _Pragma("unroll") for (int m = 0; m < 4; ++m) _Pragma("unroll") for (int n = 0; n < 2; ++n) _Pragma("unroll") for (int k = 0; k < 2; ++k) \
        acc[ai][bj][m][n] = __builtin_amdgcn_mfma_f32_16x16x32_bf16(Bt[n][k], At[m][k], acc[ai][bj][m][n], 0, 0, 0); __builtin_amdgcn_s_setprio(0); } while (0)
#define PG8_WAIT_V(n) asm volatile("s_waitcnt vmcnt(" #n ")" ::: "memory")
#define PG8_WAIT_L(n) asm volatile("s_waitcnt lgkmcnt(" #n ")" ::: "memory")
#define PG8_BAR __builtin_amdgcn_s_barrier()
#define PG8_SCHED __builtin_amdgcn_sched_barrier(0)
    Unit cur, nxt; int ui = 0;
    if (!S.next(0, cur)) return;
    f32x4 acc[2][2][4][2];
#pragma unroll
    for (int a = 0; a < 2; ++a)
#pragma unroll
        for (int b = 0; b < 2; ++b)
#pragma unroll
            for (int m = 0; m < 4; ++m)
#pragma unroll
                for (int n = 0; n < 2; ++n) acc[a][b][m][n] = (f32x4){0.f, 0.f, 0.f, 0.f};
    bf16x8 At[4][2], B0[2][2], B1[2][2];
    const char* cA = (const char*)g.A + (size_t)cur.pm * tstepA + (size_t)cur.ka * 2; const char* cB = (const char*)g.Bt + (size_t)cur.pn * tstepB;
    if constexpr (SP2) {
        PG8_STAGE(PG8_SB(0, 0), cB, voffB); PG8_STAGE(PG8_SB(0, 1), cB + hstepB, voffB); PG8_STAGE(PG8_SA(0, 0), cA, voffA); PG8_STAGE(PG8_SA(0, 1), cA + hstepA, voffA);
        if (wr == 1) PG8_BAR;
        PG8_WAIT_V(2); PG8_BAR;
        PG8_STAGE(PG8_SB(1, 0), cB + kstep, voffB); PG8_STAGE(PG8_SA(1, 0), cA + kstep, voffA); PG8_STAGE(PG8_SB(1, 1), cB + hstepB + kstep, voffB);
        PG8_WAIT_V(6); PG8_BAR;
    } else {
        PG8_STAGE(PG8_SB(0, 0), cB, voffB); PG8_STAGE(PG8_SA(0, 0), cA, voffA); PG8_STAGE(PG8_SB(0, 1), cB + hstepB, voffB); PG8_STAGE(PG8_SA(0, 1), cA + hstepA, voffA);
        if (wr == 1) PG8_BAR;
        PG8_WAIT_V(4); PG8_BAR;
        PG8_STAGE(PG8_SB(1, 0), cB + kstep, voffB); PG8_STAGE(PG8_SA(1, 0), cA + kstep, voffA); PG8_STAGE(PG8_SB(1, 1), cB + hstepB + kstep, voffB);
        PG8_WAIT_V(6); PG8_BAR;
    }
    for (;;) {
        const bool has_next = S.next(ui + 1, nxt);
        const char* nA = has_next ? (const char*)g.A + (size_t)nxt.pm * tstepA + (size_t)nxt.ka * 2 : cA; const char* nB = has_next ? (const char*)g.Bt + (size_t)nxt.pn * tstepB : cB;
        for (int t = 0; t < nt; t += 2) {
            const bool last = (t == nt - 2);
            const char* a1 = cA + (size_t)(t + 1) * kstep;
            const char* a2 = last ? nA : cA + (size_t)(t + 2) * kstep; const char* b2 = last ? nB : cB + (size_t)(t + 2) * kstep;
            const char* a3 = a2 + kstep; const char* b3 = b2 + kstep;
            if constexpr (SP2) {
            PG8_LDB(B0, 0, 0); PG8_LDB(B1, 0, 1); PG8_SCHED; PG8_LDA(At, 0, 0); PG8_STAGE(PG8_SA(1, 1), a1 + hstepA, voffA);
            PG8_WAIT_V(8); PG8_WAIT_L(0); PG8_BAR; PG8_MMA(0, 0, At, B0); PG8_MMA(0, 1, At, B1); PG8_BAR; PG8_SCHED;
            PG8_LDA(At, 0, 1); PG8_STAGE(PG8_SB(0, 0), b2, voffB); PG8_STAGE(PG8_SB(0, 1), b2 + hstepB, voffB); PG8_STAGE(PG8_SA(0, 0), a2, voffA);
            PG8_WAIT_V(8); PG8_WAIT_L(0); PG8_BAR; PG8_MMA(1, 0, At, B0); PG8_MMA(1, 1, At, B1); PG8_BAR; PG8_SCHED;
            PG8_LDB(B0, 1, 0); PG8_LDB(B1, 1, 1); PG8_SCHED; PG8_LDA(At, 1, 0); PG8_STAGE(PG8_SA(0, 1), a2 + hstepA, voffA);
            PG8_WAIT_V(8); PG8_WAIT_L(0); PG8_BAR; PG8_MMA(0, 0, At, B0); PG8_MMA(0, 1, At, B1); PG8_BAR; PG8_SCHED;
            PG8_LDA(At, 1, 1); PG8_STAGE(PG8_SB(1, 0), b3, voffB); PG8_STAGE(PG8_SB(1, 1), b3 + hstepB, voffB); PG8_STAGE(PG8_SA(1, 0), a3, voffA);
            PG8_WAIT_V(8); PG8_WAIT_L(0); PG8_BAR; PG8_MMA(1, 0, At, B0); PG8_MMA(1, 1, At, B1); PG8_BAR; PG8_SCHED;
            } else {
            PG8_LDB(B0, 0, 0); PG8_SCHED; PG8_LDA(At, 0, 0); PG8_STAGE(PG8_SA(1, 1), a1 + hstepA, voffA);
            PG8_WAIT_L(8); PG8_BAR; PG8_WAIT_L(0); PG8_MMA(0, 0, At, B0); PG8_BAR; PG8_SCHED;
            PG8_LDB(B1, 0, 1); PG8_STAGE(PG8_SB(0, 0), b2, voffB);
            PG8_BAR; PG8_WAIT_L(0); PG8_MMA(0, 1, At, B1); PG8_BAR;
            PG8_LDA(At, 0, 1); PG8_STAGE(PG8_SA(0, 0), a2, voffA);
            PG8_BAR; PG8_WAIT_L(0); PG8_MMA(1, 0, At, B0); PG8_BAR; PG8_SCHED;
            PG8_STAGE(PG8_SB(0, 1), b2 + hstepB, voffB);
            PG8_WAIT_V(6); PG8_BAR; PG8_MMA(1, 1, At, B1); PG8_BAR;
            PG8_LDB(B0, 1, 0); PG8_SCHED; PG8_LDA(At, 1, 0); PG8_STAGE(PG8_SA(0, 1), a2 + hstepA, voffA);
            PG8_WAIT_L(8); PG8_BAR; PG8_WAIT_L(0); PG8_MMA(0, 0, At, B0); PG8_BAR; PG8_SCHED;
            PG8_LDB(B1, 1, 1); PG8_STAGE(PG8_SB(1, 0), b3, voffB);
            PG8_BAR; PG8_WAIT_L(0); PG8_MMA(0, 1, At, B1); PG8_BAR;
            PG8_LDA(At, 1, 1); PG8_STAGE(PG8_SA(1, 0), a3, voffA);
            PG8_BAR; PG8_WAIT_L(0); PG8_MMA(1, 0, At, B0); PG8_BAR; PG8_SCHED;
            PG8_STAGE(PG8_SB(1, 1), b3 + hstepB, voffB);
            PG8_WAIT_V(6); PG8_BAR; PG8_MMA(1, 1, At, B1); PG8_BAR;
            }
        }
        if constexpr (ALIGN_EPI) { if (wr == 0) PG8_BAR; }
        const bool keep = E(acc, cur, wr, wc, fr, fq);
        if (!has_next) break;
        if (!keep) {
#pragma unroll
        for (int a = 0; a < 2; ++a)
#pragma unroll
            for (int b = 0; b < 2; ++b)
#pragma unroll
                for (int m = 0; m < 4; ++m)
#pragma unroll
                    for (int n = 0; n < 2; ++n) acc[a][b][m][n] = (f32x4){0.f, 0.f, 0.f, 0.f};
        }
        cur = nxt; cA = nA; cB = nB; ++ui;
        if constexpr (ALIGN_EPI) { if (wr == 1) PG8_BAR; }
    }
    PG8_WAIT_V(0);
    if constexpr (!ALIGN_EPI) { if (wr == 0) PG8_BAR; }
    PG8_BAR;
#undef PG8_SA
#undef PG8_SB
#undef PG8_STAGE
#undef PG8_LDA
#undef PG8_LDB
#undef PG8_MMA
#undef PG8_WAIT_V
#undef PG8_WAIT_L
#undef PG8_BAR
#undef PG8_SCHED
}
}

using pg8::bf16_t; using pg8::f32x4; using pg8::u32x4; using pg8::u32x2; using pg8::Unit; using pg8::cvt_pk_bf16; using pg8::bflo; using pg8::bfhi; using pg8::sigm; using pg8::pack8;
#define LAS __attribute__((address_space(3)))

constexpr int NB = 32, SEQ = 2048, DM = 1024, MTOK = NB * SEQ, NP = MTOK / 256;
constexpr int FFH = 2816, PLE = 256;
constexpr float EPS = 1e-6f, LOG2E = 1.4426950408889634f;

constexpr size_t MiB = 1u << 20;
constexpr size_t WS_RSTD0 = 0, WS_KPART = 1 * MiB;
constexpr size_t WS_W1T = 2 * MiB, WS_WVT = 10 * MiB, WS_W3T = 12 * MiB, WS_WOT = 14 * MiB, WS_WGUT = 16 * MiB, WS_WDT = 27 * MiB, WS_WPGT = 33 * MiB, WS_WPPT = 35 * MiB;
constexpr size_t WS_SSQ1 = 36 * MiB, WS_SSQ2 = 40 * MiB, WS_SSQ3 = 44 * MiB;
constexpr size_t WS_PB = 48 * MiB;
constexpr size_t WS_XB = 80 * MiB;
constexpr size_t WS_QK = 208 * MiB;
constexpr size_t WS_VT = 464 * MiB;
constexpr size_t WS_H = 208 * MiB;
constexpr size_t WS_GT = 592 * MiB;
constexpr size_t WS_A2 = 848 * MiB;
constexpr size_t WS_END = 976 * MiB;
static_assert(WS_H + (size_t)MTOK * FFH * 2 <= WS_GT && WS_VT + (size_t)MTOK * 512 * 2 * 2 <= WS_GT, "ws map");

constexpr int RING_BYTES = 131072, RS_OFF = RING_BYTES, LDS_BYTES = 152 * 1024;

struct PanelSched {
    int pm, n, mode;
    __device__ __forceinline__ bool next(int i, Unit& u) const {
        if (i >= n) return false;
        if (mode == 0) { u.pm = pm; u.pn = i; u.ka = 0; }
        else if (mode == 2) { u.pm = i; u.pn = pm; u.ka = 0; }
        else { const int pass = i & 1; u.pm = pm; u.pn = (i >> 1) + 4 * pass; u.ka = 512 * pass; }
        return true;
    }
};

struct XcdOrder {
    int nM, nN, nwg, G, c, W;
    __device__ __forceinline__ void init(int nM_, int nN_, int G_, int c_, int W_ = 8) { nM = nM_; nN = nN_; nwg = nM * nN; G = G_; c = c_; W = W_; }
    __device__ __forceinline__ bool next(int i, Unit& u) const {
        const long L = (long)i * G + c; if (L >= nwg) return false;
        int wgid = (int)L; { const int q = nwg / 8, r = nwg % 8, xcd = wgid % 8, off = wgid / 8; wgid = (xcd < r ? xcd * (q + 1) : r * (q + 1) + (xcd - r) * q) + off; }
        const int nig = W * nN, gid = wgid / nig, fm = gid * W, gsz = (nM - fm) < W ? (nM - fm) : W;
        u.pm = fm + ((wgid % nig) % gsz); u.pn = (wgid % nig) / gsz; u.ka = 0; return true;
    }
};

struct Epi1 {
    static constexpr bool PERM = true;
    const float* rstd0; const float* bgate; bf16_t* QK; bf16_t* Gt; float* kpart;
    __device__ __forceinline__ bool operator()(f32x4 (&acc)[2][2][4][2], const Unit& u, int wr, int wc, int fr_, int fq_) const {
        int fr = fr_, fq = fq_; asm volatile("" : "+v"(fr), "+v"(fq));
        const int rowl = wr * 64 + fr, row0 = u.pm * 256 + rowl, lc0 = wc * 32 + 8 * fq, pn = u.pn;
        float rs[2][4];
#pragma unroll
        for (int ai = 0; ai < 2; ++ai)
#pragma unroll
            for (int m = 0; m < 4; ++m) rs[ai][m] = rstd0[row0 + ai * 128 + m * 16];
        if (pn < 8) {
            const int cb = pn * 256 + lc0;
#pragma unroll
            for (int ai = 0; ai < 2; ++ai)
#pragma unroll
                for (int m = 0; m < 4; ++m) {
                    bf16_t* rowp = QK + (size_t)(row0 + ai * 128 + m * 16) * 2048 + cb; const float r = rs[ai][m];
#pragma unroll
                    for (int bj = 0; bj < 2; ++bj) *(u32x4*)(rowp + bj * 128) = pack8(acc[ai][bj][m][0] * r, acc[ai][bj][m][1] * r);
                }
            if (pn >= 6) {
#pragma unroll
                for (int bj = 0; bj < 2; ++bj)
#pragma unroll
                    for (int n = 0; n < 2; ++n)
#pragma unroll
                        for (int j = 0; j < 4; ++j) {
                            float s = 0.f;
#pragma unroll
                            for (int ai = 0; ai < 2; ++ai)
#pragma unroll
                                for (int m = 0; m < 4; ++m) s += acc[ai][bj][m][n][j] * rs[ai][m];
                            s += __shfl_xor(s, 1); s += __shfl_xor(s, 2); s += __shfl_xor(s, 4); s += __shfl_xor(s, 8);
                            if (fr == 0) kpart[(size_t)(u.pm * 2 + wr) * 512 + (pn & 1) * 256 + bj * 128 + lc0 + 4 * n + j] = s;
                        }
            }
        } else {
            const int gc = (pn - 8) * 256 + lc0;
            f32x4 bv[2][2];
#pragma unroll
            for (int bj = 0; bj < 2; ++bj)
#pragma unroll
                for (int n = 0; n < 2; ++n) bv[bj][n] = *(const f32x4*)(bgate + gc + bj * 128 + 4 * n);
#pragma unroll
            for (int ai = 0; ai < 2; ++ai)
#pragma unroll
                for (int m = 0; m < 4; ++m) {
                    bf16_t* rowp = Gt + (size_t)(row0 + ai * 128 + m * 16) * 2048 + gc; const float r = rs[ai][m];
#pragma unroll
                    for (int bj = 0; bj < 2; ++bj) {
                        f32x4 v0 = acc[ai][bj][m][0] * r + bv[bj][0], v1 = acc[ai][bj][m][1] * r + bv[bj][1];
#pragma unroll
                        for (int j = 0; j < 4; ++j) { v0[j] = sigm(v0[j]); v1[j] = sigm(v1[j]); }
                        *(u32x4*)(rowp + bj * 128) = pack8(v0, v1);
                    }
                }
        }
        return false;
    }
};

struct EpiVT {
    static constexpr bool PERM = true;
    const float* rstd0; bf16_t* VT;
    __device__ __forceinline__ bool operator()(f32x4 (&acc)[2][2][4][2], const Unit& u, int wr, int wc, int fr_, int fq_) const {
        int fr = fr_, fq = fq_; asm volatile("" : "+v"(fr), "+v"(fq));
        const int b = u.pn >> 3, t0 = (u.pn & 7) * 256 + wc * 32 + 8 * fq;
        f32x4 rv[2][2];
#pragma unroll
        for (int bj = 0; bj < 2; ++bj)
#pragma unroll
            for (int n = 0; n < 2; ++n) rv[bj][n] = *(const f32x4*)(rstd0 + (size_t)b * SEQ + t0 + bj * 128 + 4 * n);
#pragma unroll
        for (int ai = 0; ai < 2; ++ai)
#pragma unroll
            for (int m = 0; m < 4; ++m) {
                const int vr = u.pm * 256 + ai * 128 + wr * 64 + m * 16 + fr;
                bf16_t* rowp = VT + ((size_t)(((vr >> 9) * 32 + b) * 512 + (vr & 511))) * 2048 + t0;
#pragma unroll
                for (int bj = 0; bj < 2; ++bj) *(u32x4*)(rowp + bj * 128) = pack8(acc[ai][bj][m][0] * rv[bj][0], acc[ai][bj][m][1] * rv[bj][1]);
            }
        return false;
    }
};

struct Epi3 {
    static constexpr bool PERM = true;
    const bf16_t* Gt; bf16_t* mix;
    __device__ __forceinline__ bool operator()(f32x4 (&acc)[2][2][4][2], const Unit& u, int wr, int wc, int fr_, int fq_) const {
        int fr = fr_, fq = fq_; asm volatile("" : "+v"(fr), "+v"(fq));
        const int pass = u.pn >> 2, nc = (u.pn & 3) * 256 + wc * 32 + 8 * fq, row0 = u.pm * 256 + wr * 64 + fr;
#pragma unroll
        for (int ai = 0; ai < 2; ++ai)
#pragma unroll
            for (int m = 0; m < 4; ++m) {
                const size_t row = (size_t)(row0 + ai * 128 + m * 16); const bf16_t* gp = Gt + row * 2048 + nc + pass * 1024;
#pragma unroll
                for (int bj = 0; bj < 2; ++bj) {
                    const u32x4 gg = *(const u32x4*)(gp + bj * 128);
                    const f32x4 g0 = {bflo(gg.x), bfhi(gg.x), bflo(gg.y), bfhi(gg.y)}, g1 = {bflo(gg.z), bfhi(gg.z), bflo(gg.w), bfhi(gg.w)};
                    f32x4 v0 = acc[ai][bj][m][0] * g0, v1 = acc[ai][bj][m][1] * g1;
                    u32x4* mp = (u32x4*)(mix + row * 1024 + nc + bj * 128);
                    if (pass == 1) { const u32x4 t = *mp;
                        v0 += (f32x4){bflo(t.x), bfhi(t.x), bflo(t.y), bfhi(t.y)}; v1 += (f32x4){bflo(t.z), bfhi(t.z), bflo(t.w), bfhi(t.w)}; }
                    *mp = pack8(v0, v1);
                }
            }
        return false;
    }
};

template <int MODE> struct EpiRes {
    static constexpr bool PERM = true;
    const float* base; const bf16_t* baseb; bf16_t* xb; float* ssq; const bf16_t* PP; const LAS float* rs;
    __device__ __forceinline__ bool operator()(f32x4 (&acc)[2][2][4][2], const Unit& u, int wr, int wc, int fr_, int fq_) const {
        int fr = fr_, fq = fq_; asm volatile("" : "+v"(fr), "+v"(fq));
        const int rl = wr * 64 + fr, c0 = u.pn * 256 + wc * 32 + 8 * fq;
#pragma unroll
        for (int ai = 0; ai < 2; ++ai)
#pragma unroll
            for (int m = 0; m < 4; ++m) {
                const int rloc = ai * 128 + m * 16 + rl; const size_t row = (size_t)u.pm * 256 + rloc; float ss = 0.f; const float r = MODE == 1 ? rs[rloc] : 0.f;
#pragma unroll
                for (int bj = 0; bj < 2; ++bj) {
                    const size_t off = row * 1024 + c0 + bj * 128; f32x4 b0, b1, v0, v1;
                    if (MODE == 0) { b0 = *(const f32x4*)(base + off); b1 = *(const f32x4*)(base + off + 4); }
                    else { const u32x4 t = *(const u32x4*)(baseb + off); b0 = (f32x4){bflo(t.x), bfhi(t.x), bflo(t.y), bfhi(t.y)}; b1 = (f32x4){bflo(t.z), bfhi(t.z), bflo(t.w), bfhi(t.w)}; }
                    if (MODE != 1) { v0 = b0 + acc[ai][bj][m][0]; v1 = b1 + acc[ai][bj][m][1]; }
                    else { const u32x4 t = *(const u32x4*)(PP + off + row * 1024);
                        const f32x4 p0 = {bflo(t.x), bfhi(t.x), bflo(t.y), bfhi(t.y)}, p1 = {bflo(t.z), bfhi(t.z), bflo(t.w), bfhi(t.w)};
                        f32x4 a0 = acc[ai][bj][m][0] * r, a1 = acc[ai][bj][m][1] * r;
#pragma unroll
                        for (int j = 0; j < 4; ++j) { a0[j] = sigm(a0[j]); a1[j] = sigm(a1[j]); }
                        v0 = b0 + a0 * p0; v1 = b1 + a1 * p1; }
                    ss += ((v0[0] * v0[0] + v0[1] * v0[1]) + (v0[2] * v0[2] + v0[3] * v0[3])) + ((v1[0] * v1[0] + v1[1] * v1[1]) + (v1[2] * v1[2] + v1[3] * v1[3]));
                    *(u32x4*)(xb + off) = pack8(v0, v1);
                }
                ss += __shfl_xor(ss, 16); ss += __shfl_xor(ss, 32);
                if (fq == 0) ssq[row * 16 + u.pn * 4 + wc] = ss;
            }
        return false;
    }
};

struct Epi5 {
    static constexpr bool PERM = true;
    bf16_t* H; const LAS float* rs;
    __device__ __forceinline__ bool operator()(f32x4 (&acc)[2][2][4][2], const Unit& u, int wr, int wc, int fr_, int fq_) const {
        int fr = fr_, fq = fq_; asm volatile("" : "+v"(fr), "+v"(fq));
        const int rl = wr * 64 + fr, hc = u.pn * 128 + wc * 32 + 8 * fq;
#pragma unroll
        for (int ai = 0; ai < 2; ++ai)
#pragma unroll
            for (int m = 0; m < 4; ++m) {
                const int rloc = ai * 128 + m * 16 + rl; const size_t row = (size_t)u.pm * 256 + rloc; const float r = rs[rloc];
                f32x4 h[2];
#pragma unroll
                for (int n = 0; n < 2; ++n) { const f32x4 g = acc[ai][0][m][n] * r, up = acc[ai][1][m][n] * r;
#pragma unroll
                    for (int j = 0; j < 4; ++j) h[n][j] = g[j] * sigm(g[j]) * up[j]; }
                *(u32x4*)(H + row * FFH + hc) = pack8(h[0], h[1]);
            }
        return false;
    }
};

struct EpiPP {
    static constexpr bool PERM = true;
    bf16_t* out;
    __device__ __forceinline__ bool operator()(f32x4 (&acc)[2][2][4][2], const Unit& u, int wr, int wc, int fr_, int fq_) const {
        int fr = fr_, fq = fq_; asm volatile("" : "+v"(fr), "+v"(fq));
        const int rl = wr * 64 + fr, c0 = u.pn * 256 + wc * 32 + 8 * fq;
#pragma unroll
        for (int ai = 0; ai < 2; ++ai)
#pragma unroll
            for (int m = 0; m < 4; ++m) { const size_t row = (size_t)u.pm * 256 + ai * 128 + m * 16 + rl;
#pragma unroll
                for (int bj = 0; bj < 2; ++bj) *(u32x4*)(out + row * 2048 + c0 + bj * 128) = pack8(acc[ai][bj][m][0], acc[ai][bj][m][1]); }
        return false;
    }
};

namespace att {
typedef short bf16x8 __attribute__((ext_vector_type(8)));
typedef float f32x16 __attribute__((ext_vector_type(16)));
#define MFMA32(a, b, c) __builtin_amdgcn_mfma_f32_32x32x16_bf16((a), (b), (c), 0, 0, 0)
__device__ __forceinline__ int swap23(int r) { return (r & 0x13) | ((r & 4) << 1) | ((r & 8) >> 1); }
__device__ __forceinline__ float bf2f(short b) { return __uint_as_float(((unsigned)(unsigned short)b) << 16); }
__device__ __forceinline__ bf16x8 pack8f(const float* p) {
    u32x4 w; w.x = cvt_pk_bf16(p[0], p[1]); w.y = cvt_pk_bf16(p[2], p[3]); w.z = cvt_pk_bf16(p[4], p[5]); w.w = cvt_pk_bf16(p[6], p[7]);
    return __builtin_bit_cast(bf16x8, w);
}
struct Frag { bf16x8 k[4]; bf16x8 v[2][2]; };
__device__ __forceinline__ void load_tile(Frag& f, const bf16_t* kp, const bf16_t* vp) {
#pragma unroll
    for (int s = 0; s < 4; ++s) f.k[s] = *(const bf16x8*)(kp + 16 * s);
#pragma unroll
    for (int dt = 0; dt < 2; ++dt)
#pragma unroll
        for (int g = 0; g < 2; ++g) f.v[dt][g] = *(const bf16x8*)(vp + (size_t)dt * 32 * 2048 + 16 * g);
}
__device__ __forceinline__ void store_o(bf16_t* op, const f32x16& o0, const f32x16& o1, float inv) {
    float t[8];
#pragma unroll
    for (int g = 0; g < 2; ++g) {
#pragma unroll
        for (int e = 0; e < 8; ++e) t[e] = o0[8 * g + e] * inv;
        *(bf16x8*)(op + 16 * g) = pack8f(t);
#pragma unroll
        for (int e = 0; e < 8; ++e) t[e] = o1[8 * g + e] * inv;
        *(bf16x8*)(op + 32 + 16 * g) = pack8f(t);
    }
}

__device__ __forceinline__ void moba_wave(int b, int h, int c, int sub, const bf16_t* QK, const bf16_t* VT, const float* kpart, bf16_t* O,
                                          const LAS float* lut, LAS float* kb, int lane) {
    const int ql = lane & 31, hi = lane >> 5;
    const int tq = c * 256 + sub * 32 + ql;
    const size_t qrow = (size_t)b * SEQ + tq;
    { float ka[7], kc[7];
#pragma unroll
      for (int j = 0; j < 7; ++j) { const float* kp = kpart + (size_t)((b * 8 + (j < c ? j : 0)) * 2) * 512 + h * 64 + lane; ka[j] = kp[0]; kc[j] = kp[512]; }
#pragma unroll
      for (int j = 0; j < 7; ++j) if (j < c) kb[j * 64 + lane] = (ka[j] + kc[j]) * (1.f / 256.f); }
    asm volatile("s_waitcnt lgkmcnt(0)" ::: "memory");
    bf16x8 qf[4];
    { const bf16_t* qp = QK + qrow * 2048 + 1024 + h * 64 + 8 * hi;
#pragma unroll
      for (int s = 0; s < 4; ++s) qf[s] = *(const bf16x8*)(qp + 16 * s); }
    unsigned sel;
    if (c <= 3) sel = (1u << c) - 1u;
    else {
        float g[7];
#pragma unroll
        for (int j = 0; j < 7; ++j) {
            float a = -INFINITY;
            if (j < c) {
                a = 0.f;
#pragma unroll
                for (int s = 0; s < 4; ++s)
#pragma unroll
                    for (int e = 0; e < 8; ++e) a += bf2f(qf[s][e]) * kb[j * 64 + 16 * s + 8 * hi + e];
                a += __shfl_xor(a, 32);
            }
            g[j] = a;
        }
        sel = 0u;
#pragma unroll
        for (int k = 0; k < 3; ++k) {
            float best = -INFINITY; int bi = 0;
#pragma unroll
            for (int j = 0; j < 7; ++j) { const bool t = !((sel >> j) & 1u) && g[j] > best; best = t ? g[j] : best; bi = t ? j : bi; }
            sel |= 1u << bi;
        }
    }
    unsigned rem = 0u;
    for (int j = 0; j < c; ++j) if (__ballot((sel >> j) & 1u) != 0ull) rem |= 1u << j;
    rem = __builtin_amdgcn_readfirstlane(rem);

    const float c2 = 0.125f * LOG2E, bfar = lut[127];
    f32x16 o0, o1;
#pragma unroll
    for (int r = 0; r < 16; ++r) { o0[r] = 0.f; o1[r] = 0.f; }
    float m_run = -INFINITY, l_run = 0.f;
    const bf16_t* kbase = QK + (size_t)b * SEQ * 2048 + 1536 + h * 64 + 8 * hi + (size_t)swap23(ql) * 2048;
    const bf16_t* vbase = VT + ((size_t)((32 + b) * 8 + h) * 64 + swap23(ql)) * 2048 + 8 * hi;
    int tok = c * 256; bool in_own = true;
    Frag cur, nxt;
    load_tile(cur, kbase + (size_t)tok * 2048, vbase + tok);
    for (;;) {
        int tokn = tok; bool has_next = true;
        if (in_own && tok < c * 256 + sub * 32) tokn = tok + 32;
        else if (!in_own && (tok & 255) != 224) tokn = tok + 32;
        else if (rem) { const int j = __builtin_ctz(rem); rem &= rem - 1u; tokn = j * 256; }
        else has_next = false;
        if (has_next) load_tile(nxt, kbase + (size_t)tokn * 2048, vbase + tokn);
        {
            const int jb = tok >> 8; const bool own = (jb == c);
            f32x16 S;
#pragma unroll
            for (int r = 0; r < 16; ++r) S[r] = 0.f;
#pragma unroll
            for (int s = 0; s < 4; ++s) S = MFMA32(cur.k[s], qf[s], S);
            asm volatile("" :: "v"(cur.k[0]), "v"(cur.k[1]), "v"(cur.k[2]), "v"(cur.k[3]));
            const int dist0 = tq - tok - 8 * hi;
            const bool lanesel = own || ((sel >> jb) & 1u);
            float x[16];
            if (jb + 1 < c) {
#pragma unroll
                for (int r = 0; r < 16; ++r) x[r] = lanesel ? (S[r] * c2 + bfar) : -INFINITY;
            } else {
#pragma unroll
                for (int r = 0; r < 16; ++r) {
                    const int dist = dist0 - ((r & 7) + 16 * (r >> 3));
                    const int di = dist < 0 ? 0 : (dist > 127 ? 127 : dist);
                    const float v = S[r] * c2 + lut[di];
                    const bool valid = own ? (dist >= 0) : lanesel;
                    x[r] = valid ? v : -INFINITY;
                }
            }
            float mx = x[0];
#pragma unroll
            for (int r = 1; r < 16; ++r) mx = fmaxf(mx, x[r]);
            mx = fmaxf(mx, __shfl_xor(mx, 32));
            const float m_new = fmaxf(m_run, mx);
            const float alpha = __builtin_amdgcn_exp2f(m_run - m_new);
            float p[16]; float ls = 0.f;
#pragma unroll
            for (int r = 0; r < 16; ++r) { p[r] = __builtin_amdgcn_exp2f(x[r] - m_new); ls += p[r]; }
            l_run = l_run * alpha + ls; m_run = m_new;
#pragma unroll
            for (int r = 0; r < 16; ++r) { o0[r] *= alpha; o1[r] *= alpha; }
            const bf16x8 pb0 = pack8f(p), pb1 = pack8f(p + 8);
            o0 = MFMA32(cur.v[0][0], pb0, o0); o0 = MFMA32(cur.v[0][1], pb1, o0);
            o1 = MFMA32(cur.v[1][0], pb0, o1); o1 = MFMA32(cur.v[1][1], pb1, o1);
        }
        if (!has_next) break;
        if (in_own && tokn < tok) in_own = false;
        if (in_own && !(tok < c * 256 + sub * 32)) in_own = false;
        cur = nxt; tok = tokn;
    }
    const float l = l_run + __shfl_xor(l_run, 32);
    store_o(O + qrow * 1024 + 512 + h * 64 + 8 * hi, o0, o1, 1.f / l);
}

__device__ __forceinline__ void sb_wave(int b, int h, int qblk, int sub, const bf16_t* QK, const bf16_t* VT, bf16_t* O, int lane) {
    const int ql = lane & 31, hi = lane >> 5;
    const int tq = qblk * 256 + sub * 32 + ql;
    const size_t qrow = (size_t)b * SEQ + tq;
    bf16x8 qf[4];
    { const bf16_t* qp = QK + qrow * 2048 + h * 64 + 8 * hi;
#pragma unroll
      for (int s = 0; s < 4; ++s) qf[s] = *(const bf16x8*)(qp + 16 * s); }
    const bf16_t* kbase = QK + (size_t)b * SEQ * 2048 + 512 + h * 64 + 8 * hi + (size_t)swap23(ql) * 2048;
    const bf16_t* vbase = VT + ((size_t)(b * 8 + h) * 64 + swap23(ql)) * 2048 + 8 * hi;
    f32x16 o0, o1;
#pragma unroll
    for (int r = 0; r < 16; ++r) { o0[r] = 0.f; o1[r] = 0.f; }
    float carry = 0.f;
    const int tdiag = qblk * 256 + sub * 32;
    int tok = tdiag;
    Frag cur, nxt;
    load_tile(cur, kbase + (size_t)tok * 2048, vbase + tok);
    for (;;) {
        const bool has_next = tok > 0;
        if (has_next) load_tile(nxt, kbase + (size_t)(tok - 32) * 2048, vbase + (tok - 32));
        {
            f32x16 S;
#pragma unroll
            for (int r = 0; r < 16; ++r) S[r] = 0.f;
#pragma unroll
            for (int s = 0; s < 4; ++s) S = MFMA32(cur.k[s], qf[s], S);
            asm volatile("" :: "v"(cur.k[0]), "v"(cur.k[1]), "v"(cur.k[2]), "v"(cur.k[3]));
            const bool diag = (tok == tdiag);
            float lf[16], zl[16];
            float G0 = 0.f, G1 = 0.f;
#pragma unroll
            for (int r = 0; r < 16; ++r) {
                const int kl = (r & 7) + 8 * hi + 16 * (r >> 3);
                const float z = S[r] * 0.125f;
                const float e = __expf(-fabsf(z));
                float f = -(fmaxf(z, 0.f) + __logf(1.f + e));
                const bool causal = !diag || (kl < ql);
                zl[r] = causal ? (z + f) : -INFINITY;
                f = causal ? f : 0.f; lf[r] = f;
                if (r < 8) G0 += f; else G1 += f;
            }
            const float P0 = __shfl_xor(G0, 32), P1 = __shfl_xor(G1, 32);
            const float a0 = hi ? (P1 + G1) : ((P0 + G1) + P1), a1 = hi ? 0.f : P1;
            float w[16];
            float run = carry + a1;
#pragma unroll
            for (int e = 7; e >= 0; --e) { w[8 + e] = __expf(zl[8 + e] + run); run += lf[8 + e]; }
            run = carry + a0;
#pragma unroll
            for (int e = 7; e >= 0; --e) { w[e] = __expf(zl[e] + run); run += lf[e]; }
            carry += (G0 + G1) + (P0 + P1);
            const bf16x8 pb0 = pack8f(w), pb1 = pack8f(w + 8);
            o0 = MFMA32(cur.v[0][0], pb0, o0); o0 = MFMA32(cur.v[0][1], pb1, o0);
            o1 = MFMA32(cur.v[1][0], pb0, o1); o1 = MFMA32(cur.v[1][1], pb1, o1);
        }
        if (!has_next) break;
        if (__ballot(carry > -104.f) == 0ull) break;
        cur = nxt; tok -= 32;
    }
    store_o(O + qrow * 1024 + h * 64 + 8 * hi, o0, o1, 1.f);
}
}

namespace att2 {
using att::bf16x8; using att::f32x16; using att::Frag; using att::swap23; using att::pack8f; using att::bf2f; using att::store_o;
constexpr int BUF_BYTES = 65536;
struct Stage { u32x4 k[4]; u32x4 v[4]; };
__device__ __forceinline__ void blk_load(Stage& st, const bf16_t* kg, const bf16_t* vg, int t) {
#pragma unroll
    for (int i = 0; i < 4; ++i) { const int p = t + 512 * i; st.k[i] = *(const u32x4*)(kg + (size_t)(p >> 3) * 2048 + (p & 7) * 8); }
#pragma unroll
    for (int i = 0; i < 4; ++i) { const int p = t + 512 * i; st.v[i] = *(const u32x4*)(vg + (size_t)(p >> 5) * 2048 + (p & 31) * 8); }
}
__device__ __forceinline__ void blk_store(const Stage& st, LAS unsigned char* buf, int t) {
#pragma unroll
    for (int i = 0; i < 4; ++i) { const int p = t + 512 * i, r = p >> 3, c = p & 7; *(LAS u32x4*)(buf + r * 128 + ((c ^ ((r >> 1) & 7)) << 4)) = st.k[i]; }
#pragma unroll
    for (int i = 0; i < 4; ++i) { const int p = t + 512 * i, d = p >> 5, c = p & 31; *(LAS u32x4*)(buf + 32768 + d * 512 + ((c ^ (d & 15)) << 4)) = st.v[i]; }
}
__device__ __forceinline__ void tile_frags(Frag& f, const LAS unsigned char* buf, int kt, int sq, int hi) {
    const LAS unsigned char* kp = buf + (kt * 32 + sq) * 128; const int kx = (sq >> 1) & 7;
#pragma unroll
    for (int s = 0; s < 4; ++s) f.k[s] = *(const LAS bf16x8*)(kp + (((2 * s + hi) ^ kx) << 4));
    const int vx = sq & 15;
#pragma unroll
    for (int dt = 0; dt < 2; ++dt)
#pragma unroll
        for (int g = 0; g < 2; ++g) f.v[dt][g] = *(const LAS bf16x8*)(buf + 32768 + (32 * dt + sq) * 512 + (((4 * kt + 2 * g + hi) ^ vx) << 4));
}
__device__ __forceinline__ void wg_barrier() { __syncthreads(); }
__device__ __forceinline__ void lds_barrier() { asm volatile("s_waitcnt lgkmcnt(0)" ::: "memory"); __builtin_amdgcn_s_barrier(); asm volatile("" ::: "memory"); }

struct MobaSt { f32x16 o0, o1; float m_run, l_run; };
__device__ __forceinline__ void moba_tile(MobaSt& st, const Frag& cur, const bf16x8 (&qf)[4], int tok, int c, int tq, int hi, unsigned sel, const LAS float* lut, float bfar) {
    const float c2 = 0.125f * LOG2E;
    const int jb = tok >> 8; const bool own = (jb == c);
    f32x16 S;
#pragma unroll
    for (int r = 0; r < 16; ++r) S[r] = 0.f;
    __builtin_amdgcn_s_setprio(1);
#pragma unroll
    for (int s = 0; s < 4; ++s) S = MFMA32(cur.k[s], qf[s], S);
    __builtin_amdgcn_s_setprio(0);
    asm volatile("" :: "v"(cur.k[0]), "v"(cur.k[1]), "v"(cur.k[2]), "v"(cur.k[3]));
    float p[16]; float ls = 0.f; float m_new;
    if ((tq & ~31) - tok >= 144) {
        const bool lanesel = own || (((sel >> jb) & 1u) != 0u);
        float ms = S[0];
#pragma unroll
        for (int r = 1; r < 16; ++r) ms = fmaxf(ms, S[r]);
        float mx = lanesel ? (ms * c2 + bfar) : -INFINITY;
        mx = fmaxf(mx, __shfl_xor(mx, 32));
        m_new = fmaxf(st.m_run, mx);
        const float nb = lanesel ? (bfar - m_new) : -INFINITY;
#pragma unroll
        for (int r = 0; r < 16; ++r) { p[r] = __builtin_amdgcn_exp2f(S[r] * c2 + nb); ls += p[r]; }
    } else {
        const int dist0 = tq - tok - 8 * hi;
        const bool lanesel = own || ((sel >> jb) & 1u);
        float x[16];
#pragma unroll
        for (int r = 0; r < 16; ++r) {
            const int dist = dist0 - ((r & 7) + 16 * (r >> 3));
            const int di = dist < 0 ? 0 : (dist > 127 ? 127 : dist);
            const float v = S[r] * c2 + lut[di];
            const bool valid = own ? (dist >= 0) : lanesel;
            x[r] = valid ? v : -INFINITY;
        }
        float mx = x[0];
#pragma unroll
        for (int r = 1; r < 16; ++r) mx = fmaxf(mx, x[r]);
        mx = fmaxf(mx, __shfl_xor(mx, 32));
        m_new = fmaxf(st.m_run, mx);
#pragma unroll
        for (int r = 0; r < 16; ++r) { p[r] = __builtin_amdgcn_exp2f(x[r] - m_new); ls += p[r]; }
    }
    const float alpha = __builtin_amdgcn_exp2f(st.m_run - m_new);
    st.l_run = st.l_run * alpha + ls;
    if (__ballot(m_new > st.m_run) != 0ull) {
#pragma unroll
        for (int r = 0; r < 16; ++r) { st.o0[r] *= alpha; st.o1[r] *= alpha; }
    }
    st.m_run = m_new;
    const bf16x8 pb0 = pack8f(p), pb1 = pack8f(p + 8);
    __builtin_amdgcn_s_setprio(1);
    st.o0 = MFMA32(cur.v[0][0], pb0, st.o0); st.o1 = MFMA32(cur.v[1][0], pb0, st.o1);
    st.o0 = MFMA32(cur.v[0][1], pb1, st.o0); st.o1 = MFMA32(cur.v[1][1], pb1, st.o1);
    __builtin_amdgcn_s_setprio(0);
}

__device__ __forceinline__ void moba_unit(int b, int h, int c, int sub, const bf16_t* QK, const bf16_t* VT, const float* kpart, bf16_t* O,
                                          const LAS float* lut, LAS float* kb, LAS unsigned* ctl, LAS unsigned char* bufs, int wave, int lane, int t,
                                          Stage& stg, const bf16_t* nkg, const bf16_t* nvg) {
    const int ql = lane & 31, hi = lane >> 5, sq = swap23(ql);
    const int tq = c * 256 + sub * 32 + ql;
    const size_t qrow = (size_t)b * SEQ + tq;
    const bf16_t* kg0 = QK + (size_t)b * SEQ * 2048 + 1536 + h * 64;
    const bf16_t* vg0 = VT + ((size_t)((32 + b) * 8 + h) * 64) * 2048;
    { float ka[7], kc[7];
#pragma unroll
      for (int j = 0; j < 7; ++j) { const float* kp = kpart + (size_t)((b * 8 + (j < c ? j : 0)) * 2) * 512 + h * 64 + lane; ka[j] = kp[0]; kc[j] = kp[512]; }
#pragma unroll
      for (int j = 0; j < 7; ++j) if (j < c) kb[j * 64 + lane] = (ka[j] + kc[j]) * (1.f / 256.f); }
    asm volatile("s_waitcnt lgkmcnt(0)" ::: "memory");
    bf16x8 qf[4];
    { const bf16_t* qp = QK + qrow * 2048 + 1024 + h * 64 + 8 * hi;
#pragma unroll
      for (int s = 0; s < 4; ++s) qf[s] = *(const bf16x8*)(qp + 16 * s); }
    unsigned sel;
    if (c <= 3) sel = (1u << c) - 1u;
    else {
        float g[7];
#pragma unroll
        for (int j = 0; j < 7; ++j) {
            float a = -INFINITY;
            if (j < c) {
                a = 0.f;
#pragma unroll
                for (int s = 0; s < 4; ++s)
#pragma unroll
                    for (int e = 0; e < 8; ++e) a += bf2f(qf[s][e]) * kb[j * 64 + 16 * s + 8 * hi + e];
                a += __shfl_xor(a, 32);
            }
            g[j] = a;
        }
        sel = 0u;
#pragma unroll
        for (int k = 0; k < 3; ++k) {
            float best = -INFINITY; int bi = 0;
#pragma unroll
            for (int j = 0; j < 7; ++j) { const bool tt = !((sel >> j) & 1u) && g[j] > best; best = tt ? g[j] : best; bi = tt ? j : bi; }
            sel |= 1u << bi;
        }
    }
    unsigned remw = 0u;
    for (int j = 0; j < c; ++j) if (__ballot((sel >> j) & 1u) != 0ull) remw |= 1u << j;
    remw = __builtin_amdgcn_readfirstlane(remw);
    if (lane == 0) ctl[wave] = remw;
    blk_store(stg, bufs, t);
    __builtin_amdgcn_s_waitcnt(0x0F70);
    wg_barrier();
    unsigned rem = 0u;
#pragma unroll
    for (int w = 0; w < 8; ++w) rem |= ctl[w];
    rem = __builtin_amdgcn_readfirstlane(rem);

    MobaSt st;
#pragma unroll
    for (int r = 0; r < 16; ++r) { st.o0[r] = 0.f; st.o1[r] = 0.f; }
    st.m_run = -INFINITY; st.l_run = 0.f;
    const float bfar = lut[127];
    int jb = c, i = 0;
    for (;;) {
        int jn = -1; if (rem) { jn = __builtin_ctz(rem); rem &= rem - 1u; }
        if (jn >= 0) blk_load(stg, kg0 + (size_t)jn * 256 * 2048, vg0 + jn * 256, t);
        const LAS unsigned char* buf = bufs + (i & 1) * BUF_BYTES;
        if (jb == c || ((remw >> jb) & 1u)) {
            const int nkt = (jb == c) ? sub + 1 : 8;
            for (int kt = 0; kt < nkt; ++kt) { Frag f; tile_frags(f, buf, kt, sq, hi); moba_tile(st, f, qf, jb * 256 + kt * 32, c, tq, hi, sel, lut, bfar); }
        }
        if (jn < 0) break;
        blk_store(stg, bufs + ((i + 1) & 1) * BUF_BYTES, t);
        wg_barrier();
        jb = jn; ++i;
    }
    if (nkg) blk_load(stg, nkg, nvg, t);
    const float l = st.l_run + __shfl_xor(st.l_run, 32);
    store_o(O + qrow * 1024 + 512 + h * 64 + 8 * hi, st.o0, st.o1, 1.f / l);
    lds_barrier();
}

struct SbSt { f32x16 o0, o1; float carry; };
template <bool DIAG> __device__ __forceinline__ void sb_tile(SbSt& st, const Frag& cur, const bf16x8 (&qf)[4], int ql, int hi) {
    f32x16 S;
#pragma unroll
    for (int r = 0; r < 16; ++r) S[r] = 0.f;
    __builtin_amdgcn_s_setprio(1);
#pragma unroll
    for (int s = 0; s < 4; ++s) S = MFMA32(cur.k[s], qf[s], S);
    __builtin_amdgcn_s_setprio(0);
    asm volatile("" :: "v"(cur.k[0]), "v"(cur.k[1]), "v"(cur.k[2]), "v"(cur.k[3]));
    float bt[16], om[16];
    float G0 = 1.f, G1 = 1.f;
#pragma unroll
    for (int r = 0; r < 16; ++r) {
        const float e = __builtin_amdgcn_exp2f(-fabsf(S[r]) * (0.125f * LOG2E));
        const float rc = __builtin_amdgcn_rcpf(1.f + e), er = e * rc;
        float beta = S[r] > 0.f ? rc : er, omb = S[r] > 0.f ? er : rc;
        if (DIAG) { const int kl = (r & 7) + 8 * hi + 16 * (r >> 3); const bool causal = kl < ql; beta = causal ? beta : 0.f; omb = causal ? omb : 1.f; }
        bt[r] = beta; om[r] = omb;
        if (r < 8) G0 *= omb; else G1 *= omb;
    }
    const float P0 = __shfl_xor(G0, 32), P1 = __shfl_xor(G1, 32);
    const float a0 = hi ? (P1 * G1) : ((P0 * G1) * P1), a1 = hi ? 1.f : P1;
    float w[16];
    float run = st.carry * a1;
#pragma unroll
    for (int e = 7; e >= 0; --e) { w[8 + e] = bt[8 + e] * run; run *= om[8 + e]; }
    run = st.carry * a0;
#pragma unroll
    for (int e = 7; e >= 0; --e) { w[e] = bt[e] * run; run *= om[e]; }
    st.carry *= (G0 * G1) * (P0 * P1);
    const bf16x8 pb0 = pack8f(w), pb1 = pack8f(w + 8);
    __builtin_amdgcn_s_setprio(1);
    st.o0 = MFMA32(cur.v[0][0], pb0, st.o0); st.o1 = MFMA32(cur.v[1][0], pb0, st.o1);
    st.o0 = MFMA32(cur.v[0][1], pb1, st.o0); st.o1 = MFMA32(cur.v[1][1], pb1, st.o1);
    __builtin_amdgcn_s_setprio(0);
}
__device__ __forceinline__ bool sb_dead(const SbSt& st) { return __ballot(st.carry >= 1.17549435e-38f) == 0ull; }

__device__ __forceinline__ void sb_unit(int b, int h, int qblk, int sub, const bf16_t* QK, const bf16_t* VT, bf16_t* O,
                                        LAS unsigned* ctl, LAS unsigned char* bufs, int wave, int lane, int t, Stage& stg, const bf16_t* nkg, const bf16_t* nvg) {
    const int ql = lane & 31, hi = lane >> 5, sq = swap23(ql);
    const int tq = qblk * 256 + sub * 32 + ql;
    const size_t qrow = (size_t)b * SEQ + tq;
    const bf16_t* kg0 = QK + (size_t)b * SEQ * 2048 + 512 + h * 64;
    const bf16_t* vg0 = VT + ((size_t)(b * 8 + h) * 64) * 2048;
    Stage stg2;
    if (qblk > 0) blk_load(stg2, kg0 + (size_t)(qblk - 1) * 256 * 2048, vg0 + (qblk - 1) * 256, t);
    bf16x8 qf[4];
    { const bf16_t* qp = QK + qrow * 2048 + h * 64 + 8 * hi;
#pragma unroll
      for (int s = 0; s < 4; ++s) qf[s] = *(const bf16x8*)(qp + 16 * s); }
    if (t < 8) ctl[8 + t] = 0u;
    blk_store(stg, bufs, t);
    if (qblk > 0) blk_store(stg2, bufs + BUF_BYTES, t);
    __builtin_amdgcn_s_waitcnt(0x0F70);
    wg_barrier();
    if (nkg) blk_load(stg, nkg, nvg, t);
    SbSt st;
#pragma unroll
    for (int r = 0; r < 16; ++r) { st.o0[r] = 0.f; st.o1[r] = 0.f; }
    st.carry = 1.f;
    bool done = false;
    { Frag f; tile_frags(f, bufs, sub, sq, hi); sb_tile<true>(st, f, qf, ql, hi); done = sb_dead(st); }
    for (int kt = sub - 1; kt >= 0 && !done; --kt) { Frag f; tile_frags(f, bufs, kt, sq, hi); sb_tile<false>(st, f, qf, ql, hi); done = sb_dead(st); }
    if (qblk > 0)
        for (int kt = 7; kt >= 0 && !done; --kt) { Frag f; tile_frags(f, bufs + BUF_BYTES, kt, sq, hi); sb_tile<false>(st, f, qf, ql, hi); done = sb_dead(st); }
    int jb = qblk - 2, i = 0;
    for (;;) {
        if (!done && jb >= 0 && lane == 0) ctl[8 + i] = 1u;
        wg_barrier();
        if (jb < 0 || ctl[8 + i] == 0u) break;
        blk_load(stg2, kg0 + (size_t)jb * 256 * 2048, vg0 + jb * 256, t);
        blk_store(stg2, bufs + (i & 1) * BUF_BYTES, t);
        wg_barrier();
        for (int kt = 7; kt >= 0 && !done; --kt) { Frag f; tile_frags(f, bufs + (i & 1) * BUF_BYTES, kt, sq, hi); sb_tile<false>(st, f, qf, ql, hi); done = sb_dead(st); }
        --jb; ++i;
    }
    store_o(O + qrow * 1024 + h * 64 + 8 * hi, st.o0, st.o1, 1.f);
    lds_barrier();
}
}

__device__ __forceinline__ float wave_sum(float v) {
#pragma unroll
    for (int o = 1; o < 64; o <<= 1) v += __shfl_xor(v, o);
    return v;
}
__device__ __forceinline__ void p0_transpose_item(const float* W, int K, int N, const float* gk, bf16_t* WT, int k0, int n0, int dst_row0, LAS float* scr, int lane) {
    {
        f32x4 w4[8]; const int c4 = (lane & 7) * 4, kr = lane >> 3;
#pragma unroll
        for (int i = 0; i < 8; ++i) w4[i] = *(const f32x4*)(W + (size_t)(k0 + 8 * i + kr) * N + n0 + c4);
#pragma unroll
        for (int i = 0; i < 8; ++i) { const int kk = 8 * i + kr; f32x4 w = w4[i]; if (gk) w = w * gk[k0 + kk];
            LAS float* d = scr + kk * 33 + c4; d[0] = w[0]; d[1] = w[1]; d[2] = w[2]; d[3] = w[3]; }
    }
    asm volatile("s_waitcnt lgkmcnt(0)" ::: "memory");
    const int c = lane & 7;
#pragma unroll
    for (int j = 0; j < 4; ++j) { const int n = (lane >> 3) + 8 * j; const LAS float* s = scr + (8 * c) * 33 + n;
        u32x4 o; o.x = cvt_pk_bf16(s[0 * 33], s[1 * 33]); o.y = cvt_pk_bf16(s[2 * 33], s[3 * 33]); o.z = cvt_pk_bf16(s[4 * 33], s[5 * 33]); o.w = cvt_pk_bf16(s[6 * 33], s[7 * 33]);
        *(u32x4*)(WT + (size_t)(dst_row0 + n) * K + k0 + 8 * c) = o; }
    asm volatile("s_waitcnt lgkmcnt(0)" ::: "memory");
}

struct Args { const float* in[18]; float* out; unsigned char* ws; };

#define XB_TMO      128
#define XB_XCNT(j)  (256  + 64 * (j))
#define XB_XSUB(j)  (1280 + 64 * (j))
#define XB_XGEN(j)  (2304 + 64 * (j))
#define XB_TOP      3328
#define XB_TOPGEN   3392
#define XCD_BAR_WORDS 3456
#define XB_SPIN_CAP (1u << 18)

__device__ __forceinline__ unsigned xb_ld(unsigned* p)              { return __hip_atomic_load(p, __ATOMIC_RELAXED, __HIP_MEMORY_SCOPE_AGENT); }
__device__ __forceinline__ unsigned xb_add(unsigned* p, unsigned v) { return __hip_atomic_fetch_add(p, v, __ATOMIC_RELAXED, __HIP_MEMORY_SCOPE_AGENT); }
__device__ __forceinline__ unsigned xb_xcc_id() { return (unsigned)__builtin_amdgcn_s_getreg((3 << 11) | 20) & 0xFu; }
#define XB_SPIN(cond, bar) do { unsigned _sp = 0; while (cond) { __builtin_amdgcn_s_sleep(1); \
    if ((++_sp & 255u) == 0u) { if (xb_ld(&(bar)[XB_TMO])) break; if (_sp > XB_SPIN_CAP) { atomicAdd(&(bar)[XB_TMO], 1u); break; } } } } while (0)

struct XcdBarrier {
    unsigned* bar; unsigned x;
    volatile LAS unsigned* st;
};

__device__ __forceinline__ XcdBarrier xcd_barrier_post(unsigned* bar, volatile LAS unsigned* st) {
    XcdBarrier b; b.bar = bar; b.x = xb_xcc_id(); b.st = st;
    if (threadIdx.x == 0) (void)xb_add(&bar[XB_XCNT(b.x)], 1u);
    return b;
}
__device__ __forceinline__ void xcd_barrier_complete(unsigned* bar, unsigned x, unsigned& nloc, unsigned& nx) {
    const unsigned G = gridDim.x * gridDim.y * gridDim.z;
    unsigned sum, cnt, mine, sp = 0u;
    for (;;) {
        sum = 0u; cnt = 0u; mine = 0u;
#pragma unroll
        for (unsigned j = 0; j < 16; ++j) { const unsigned c = xb_ld(&bar[XB_XCNT(j)]); sum += c; cnt += (c > 0u) ? 1u : 0u; mine = (j == x) ? c : mine; }
        if (sum == G) break;
        __builtin_amdgcn_s_sleep(1);
        if ((++sp & 255u) == 0u) { if (xb_ld(&bar[XB_TMO])) break; if (sp > XB_SPIN_CAP) { atomicAdd(&bar[XB_TMO], 1u); break; } }
    }
    nloc = mine > 0u ? mine : 1u; nx = cnt > 0u ? cnt : 1u;
}

__device__ __forceinline__ void xcd_barrier(const XcdBarrier& b) {
    asm volatile("s_waitcnt vmcnt(0)" ::: "memory");
    __syncthreads();
    if (threadIdx.x == 0) {
        unsigned* bar = b.bar;
        __builtin_amdgcn_s_waitcnt(0);
        unsigned nloc = b.st[0], nx = b.st[1];
        if (nloc == 0u) { xcd_barrier_complete(bar, b.x, nloc, nx); b.st[0] = nloc; b.st[1] = nx; }
        const unsigned old = xb_add(&bar[XB_XSUB(b.x)], 1u);
        const unsigned gen = old / nloc;
        if (old + 1u == (gen + 1u) * nloc) {
            __builtin_amdgcn_fence(__ATOMIC_RELEASE, "agent");
            asm volatile("s_waitcnt vmcnt(0)" ::: "memory");
            const unsigned og = xb_add(&bar[XB_TOP], 1u);
            const unsigned tg = og / nx;
            if (og + 1u == (tg + 1u) * nx) xb_add(&bar[XB_TOPGEN], 1u);
            else XB_SPIN(xb_ld(&bar[XB_TOPGEN]) == tg, bar);
            __builtin_amdgcn_fence(__ATOMIC_ACQUIRE, "agent");
            xb_add(&bar[XB_XGEN(b.x)], 1u);
            asm volatile("s_waitcnt vmcnt(0)" ::: "memory");
        } else {
            XB_SPIN(xb_ld(&bar[XB_XGEN(b.x)]) == gen, bar);
            __builtin_amdgcn_fence(__ATOMIC_ACQUIRE, "agent");
            asm volatile("s_waitcnt vmcnt(0)" ::: "memory");
        }
    }
    __syncthreads();
}

__device__ __forceinline__ void chain_fence() { __builtin_amdgcn_fence(__ATOMIC_ACQUIRE, "workgroup"); }
__device__ __forceinline__ void compute_rs(const float* ssq, int pm, LAS float* rs, int tid_) {
    int tid = tid_; asm volatile("" : "+v"(tid));
    if (tid < 256) { const f32x4* p = (const f32x4*)(ssq + (size_t)(pm * 256 + tid) * 16); const f32x4 a = p[0], b = p[1], c = p[2], d = p[3];
        const float s = (((a[0] + a[1]) + (a[2] + a[3])) + ((b[0] + b[1]) + (b[2] + b[3]))) + (((c[0] + c[1]) + (c[2] + c[3])) + ((d[0] + d[1]) + (d[2] + d[3])));
        rs[tid] = rsqrtf(s * (1.f / DM) + EPS); }
    __syncthreads();
}

__device__ __forceinline__ int lane_id_() { int l; asm volatile("v_mbcnt_lo_u32_b32 %0, -1, 0\n\tv_mbcnt_hi_u32_b32 %0, -1, %0" : "=v"(l)); return l; }
template <int PLO, int PHI>
__global__ void __launch_bounds__(512, 2) fwd_megakernel(Args args) {
    extern __shared__ __attribute__((aligned(16))) unsigned char lds_raw[];
    LAS unsigned char* lds = (LAS unsigned char*)lds_raw;
    cg::grid_group grid = cg::this_grid();
    const int wave = __builtin_amdgcn_readfirstlane((int)threadIdx.x >> 6);
#define lane (lane_id_())
#define tid (wave * 64 + lane)
    const int G = gridDim.x, bx = blockIdx.x;
    unsigned char* ws = args.ws;
    const float* x = args.in[0]; float* out = args.out;
    float* rstd0 = (float*)(ws + WS_RSTD0); float* kpart = (float*)(ws + WS_KPART);
    bf16_t* W1t = (bf16_t*)(ws + WS_W1T); bf16_t* Wvt = (bf16_t*)(ws + WS_WVT); bf16_t* W3t = (bf16_t*)(ws + WS_W3T); bf16_t* Wot = (bf16_t*)(ws + WS_WOT); bf16_t* Wgut = (bf16_t*)(ws + WS_WGUT);
    bf16_t* Wdt = (bf16_t*)(ws + WS_WDT); bf16_t* Wpgt = (bf16_t*)(ws + WS_WPGT); bf16_t* Wppt = (bf16_t*)(ws + WS_WPPT);
    float* ssq1 = (float*)(ws + WS_SSQ1); float* ssq2 = (float*)(ws + WS_SSQ2); float* ssq3 = (float*)(ws + WS_SSQ3);
    bf16_t* PB = (bf16_t*)(ws + WS_PB); bf16_t* XB = (bf16_t*)(ws + WS_XB); bf16_t* QK = (bf16_t*)(ws + WS_QK); bf16_t* VT = (bf16_t*)(ws + WS_VT);
    bf16_t* HB = (bf16_t*)(ws + WS_H); bf16_t* Gt = (bf16_t*)(ws + WS_GT); bf16_t* PP = (bf16_t*)out; bf16_t* A2 = (bf16_t*)(ws + WS_A2);
    bf16_t* MIX = XB; bf16_t* XB2 = XB; bf16_t* XB1 = A2; bf16_t* XB3 = A2;
    LAS float* rs = (LAS float*)(lds + RS_OFF);
    volatile LAS unsigned* xb_st = (volatile LAS unsigned*)(lds + 151680);
    if (threadIdx.x < 2) xb_st[threadIdx.x] = 0u;
    __syncthreads();
    XcdBarrier xbar = xcd_barrier_post((unsigned*)(ws + WS_RSTD0 + 512 * 1024), xb_st);
    if (args.ws == nullptr) grid.sync();
#if PROBE_T
    const unsigned long long t_start = __builtin_amdgcn_s_memrealtime(); float t_probe = 0.f;
#define STAMP(k) do { if (PROBE_T == (k)) t_probe = (float)(__builtin_amdgcn_s_memrealtime() - t_start) * 0.01f; } while (0)
#else
#define STAMP(k) do {} while (0)
#endif

#define PH_IN(k) (PLO <= (k) && (k) < PHI)
    if constexpr (PH_IN(0)) {
        LAS float* scr = (LAS float*)(lds + wave * 16384);
        const int gw = bx * 8 + wave, NGW = G * 8;
        constexpr int I1 = 16 * 96, I2 = 16 * 64, I3 = 8 * 32, I5 = 16 * 32, I6 = 16 * 88, I8 = 44 * 32, I10 = 4 * 32;
        constexpr int NITEMS = I1 + I2 + 2 * I3 + I5 + 2 * I6 + I8 + I5 + I10;
        for (int it = gw; it < NITEMS; it += NGW) {
            int r = it;
            if (r < I1) { const int kb = r / 96, nb = r % 96, n0 = 32 * nb, grp = n0 >> 9, o = n0 & 511;
                bf16_t* dW = (grp == 2 || grp == 5) ? Wvt : W1t; const int dr = (grp == 2 ? 0 : grp == 5 ? 512 : grp == 0 ? 0 : grp == 1 ? 512 : grp == 3 ? 1024 : 1536) + o;
                p0_transpose_item(args.in[3], 1024, 3072, args.in[2], dW, 64 * kb, n0, dr, scr, lane); continue; } r -= I1;
            if (r < I2) { const int kb = r / 64, nb = r % 64; p0_transpose_item(args.in[4], 1024, 2048, args.in[2], W1t, 64 * kb, 32 * nb, 2048 + 32 * nb, scr, lane); continue; } r -= I2;
            if (r < I3) { const int kb = r / 32, nb = r % 32; p0_transpose_item(args.in[6], 512, 1024, nullptr, W3t, 64 * kb, 32 * nb, 32 * nb, scr, lane); continue; } r -= I3;
            if (r < I3) { const int kb = r / 32, nb = r % 32; p0_transpose_item(args.in[7], 512, 1024, nullptr, W3t, 64 * kb, 32 * nb, 1024 + 32 * nb, scr, lane); continue; } r -= I3;
            if (r < I5) { const int kb = r / 32, nb = r % 32; p0_transpose_item(args.in[8], 1024, 1024, nullptr, Wot, 64 * kb, 32 * nb, 32 * nb, scr, lane); continue; } r -= I5;
            if (r < I6) { const int kb = r / 88, nb = r % 88, n0 = 32 * nb; p0_transpose_item(args.in[11], 1024, FFH, args.in[10], Wgut, 64 * kb, n0, 256 * (n0 >> 7) + (n0 & 127), scr, lane); continue; } r -= I6;
            if (r < I6) { const int kb = r / 88, nb = r % 88, n0 = 32 * nb; p0_transpose_item(args.in[12], 1024, FFH, args.in[10], Wgut, 64 * kb, n0, 256 * (n0 >> 7) + 128 + (n0 & 127), scr, lane); continue; } r -= I6;
            if (r < I8) { const int kb = r / 32, nb = r % 32; p0_transpose_item(args.in[13], FFH, 1024, nullptr, Wdt, 64 * kb, 32 * nb, 32 * nb, scr, lane); continue; } r -= I8;
            if (r < I5) { const int kb = r / 32, nb = r % 32; p0_transpose_item(args.in[15], 1024, 1024, args.in[14], Wpgt, 64 * kb, 32 * nb, 32 * nb, scr, lane); continue; } r -= I5;
            { const int kb = r / 32, nb = r % 32; p0_transpose_item(args.in[16], PLE, 1024, nullptr, Wppt, 64 * kb, 32 * nb, 32 * nb, scr, lane); }
        }
        for (int m0 = gw * 32; m0 < MTOK; m0 += NGW * 32)
        for (int m = m0; m < m0 + 32; ++m) {
            const f32x4* xr = (const f32x4*)(x + (size_t)m * DM) + lane; f32x4 v[4]; float s = 0.f;
#pragma unroll
            for (int j = 0; j < 4; ++j) { v[j] = xr[64 * j]; s += (v[j][0] * v[j][0] + v[j][1] * v[j][1]) + (v[j][2] * v[j][2] + v[j][3] * v[j][3]); }
            s = wave_sum(s);
            if (lane == 0) rstd0[m] = rsqrtf(s * (1.f / DM) + EPS);
            u32x2* o8 = (u32x2*)(XB + (size_t)m * DM) + lane;
#pragma unroll
            for (int j = 0; j < 4; ++j) { u32x2 w; w.x = cvt_pk_bf16(v[j][0], v[j][1]); w.y = cvt_pk_bf16(v[j][2], v[j][3]); o8[64 * j] = w; }
        }
        const float* p = args.in[1];
        for (size_t i = (size_t)bx * 512 + tid; i < (size_t)MTOK * PLE / 8; i += (size_t)G * 512) {
            const f32x4 a = *(const f32x4*)(p + i * 8), b = *(const f32x4*)(p + i * 8 + 4);
            *(u32x4*)(PB + i * 8) = pack8(a, b);
        }
    }
    if constexpr (PH_IN(0) && PH_IN(1)) {
    xcd_barrier(xbar);
    }
    STAMP(1);

    if constexpr (PH_IN(1)) if (bx < NP) for (int rep_ = 0; rep_ < REP_P1; ++rep_) { const int pm = bx;
        { pg8::Gemm g{XB, W1t, 1024, 1024}; XcdOrder S; S.init(NP, 16, G, bx, 4);
          Epi1 E{rstd0, args.in[5], QK, Gt, kpart};
          pg8::gemm_phase<Epi1, XcdOrder, true, true>(lds, g, S, E, wave); }
        { pg8::Gemm g{Wvt, XB, 1024, 1024}; XcdOrder S; S.init(4, NP, G, bx);
          EpiVT E{rstd0, VT};
          pg8::gemm_phase<EpiVT, XcdOrder, true, true>(lds, g, S, E, wave); }
        { pg8::Gemm g{PB, Wppt, PLE, PLE}; XcdOrder S; S.init(NP, 4, G, bx);
          EpiPP E{PP};
          pg8::gemm_phase<EpiPP, XcdOrder, true, true>(lds, g, S, E, wave); }
    }
    if constexpr (PH_IN(1) && PH_IN(2)) {
    xcd_barrier(xbar);
    }
    STAMP(2);

    if constexpr (PH_IN(2)) {
        LAS float* lut = (LAS float*)(lds + 131072);
        LAS float* kb = (LAS float*)(lds + 135168 + wave * 2048);
        LAS unsigned* ctl = (LAS unsigned*)(lds + 151552);
        const float* rel_bias = args.in[9];
        for (int i = tid; i < 1024; i += 512) { const int hh = i >> 7, d = i & 127;
            int bk = d; if (d >= 16) { bk = 16 + (int)(logf((float)d / 16.f) / logf(8.f) * 16.f); bk = bk > 31 ? 31 : bk; }
            lut[i] = rel_bias[bk * 8 + hh] * LOG2E; }
        __syncthreads();
#define UNIT_KG(u) (QK + (size_t)(((u) & 255) >> 3) * SEQ * 2048 + ((u) < 2048 ? 1536 : 512) + (((u) & 255) & 7) * 64 + (size_t)(7 - (((u) & 2047) >> 8)) * 256 * 2048)
#define UNIT_VG(u) (VT + ((size_t)((((u) < 2048 ? 32 : 0) + (((u) & 255) >> 3)) * 8 + (((u) & 255) & 7)) * 64) * 2048 + (7 - (((u) & 2047) >> 8)) * 256)
        att2::Stage stg;
        if (bx < 4096) att2::blk_load(stg, UNIT_KG(bx), UNIT_VG(bx), tid);
        int ui = 0;
        for (int u_ = bx; u_ < 4096 * REP_P2; u_ += G, ++ui) { const int u = u_ & 4095;
            const int sub = (wave + ui) & 7;
            const bool hn = (u_ + G) < 4096 * REP_P2; const int un = (u_ + G) & 4095;
            const bf16_t* nkg = hn ? UNIT_KG(un) : nullptr; const bf16_t* nvg = hn ? UNIT_VG(un) : nullptr;
            if (u < 2048) { const int c = 7 - (u >> 8), bh = u & 255;
                att2::moba_unit(bh >> 3, bh & 7, c, sub, QK, VT, kpart, A2, lut + (bh & 7) * 128, kb, ctl, lds, wave, lane, tid, stg, nkg, nvg);
            } else { const int v = u - 2048, qblk = 7 - (v >> 8), bh = v & 255;
                att2::sb_unit(bh >> 3, bh & 7, qblk, sub, QK, VT, A2, ctl, lds, wave, lane, tid, stg, nkg, nvg);
            }
        }
    }
    if constexpr (PH_IN(2) && PH_IN(3)) {
    xcd_barrier(xbar);
    }
    STAMP(3);

    if constexpr (PH_IN(3)) if (bx < NP) { const int pm = bx;
#define P7A_BLOCK { pg8::Gemm g{PB, Wppt, PLE, PLE}; PanelSched S{pm, 4, 0}; EpiPP E{PP}; pg8::gemm_phase<EpiPP, PanelSched, true, true>(lds, g, S, E, wave); chain_fence(); }
        {
            pg8::Gemm g{A2, W3t, 1024, 512}; PanelSched S{pm, 8, 1}; Epi3 E{Gt, MIX};
            pg8::gemm_phase<Epi3, PanelSched, true, true>(lds, g, S, E, wave); chain_fence(); STAMP(4);
        }
        {
            pg8::Gemm g{MIX, Wot, 1024, 1024}; PanelSched S{pm, 4, 0}; EpiRes<0> E{x, nullptr, XB1, ssq1, nullptr, rs};
            pg8::gemm_phase<EpiRes<0>, PanelSched, true, true>(lds, g, S, E, wave); chain_fence(); STAMP(5);
        }
        compute_rs(ssq1, pm, rs, tid);
        for (int rep_ = 0; rep_ < REP_P5; ++rep_)
        {
            pg8::Gemm g{XB1, Wgut, 1024, 1024}; PanelSched S{pm, 22, 0}; Epi5 E{HB, rs};
            pg8::gemm_phase<Epi5, PanelSched, true, true>(lds, g, S, E, wave); chain_fence(); STAMP(6);
        }
        {
            pg8::Gemm g{HB, Wdt, FFH, FFH}; PanelSched S{pm, 4, 0}; EpiRes<2> E{nullptr, XB1, XB2, ssq2, nullptr, rs};
            pg8::gemm_phase<EpiRes<2>, PanelSched, true, true>(lds, g, S, E, wave); chain_fence(); STAMP(7);
        }
        compute_rs(ssq2, pm, rs, tid);
        {
            pg8::Gemm g{XB2, Wpgt, 1024, 1024}; PanelSched S{pm, 4, 0}; EpiRes<1> E{nullptr, XB2, XB3, ssq3, PP, rs};
            pg8::gemm_phase<EpiRes<1>, PanelSched, true, true>(lds, g, S, E, wave); chain_fence(); STAMP(8);
        }
        compute_rs(ssq3, pm, rs, tid);
        {
            const f32x4* fg = (const f32x4*)args.in[17] + lane;
            for (int r = wave; r < 256; r += 8) {
                const size_t ro = (size_t)(pm * 256 + r) * DM; const u32x2* xr = (const u32x2*)(XB3 + ro) + lane; f32x4* pr = (f32x4*)(out + ro) + lane; const float s = rs[r];
#pragma unroll
                for (int j = 0; j < 4; ++j) { const u32x2 t = xr[64 * j]; const f32x4 v = {bflo(t.x), bfhi(t.x), bflo(t.y), bfhi(t.y)}; pr[64 * j] = v * s * fg[64 * j]; }
            }
        }
        __syncthreads();
#if PROBE_T
        if (bx == 0 && tid == 0) out[0] = t_probe;
#endif
    }
}

extern "C" void kernel_launch(void* const* d_in, const int* in_sizes, int n_in, void* d_out, int out_size, void* d_ws, size_t ws_size, hipStream_t stream) {
    static int grid = 0;
    if (grid == 0) {
        if (n_in != 18 || out_size != MTOK * DM || ws_size < WS_END) { fprintf(stderr, "kernel_launch: unexpected problem shape (n_in %d, out %d, ws %zu)\n", n_in, out_size, ws_size); grid = -1; return; }
        int dev = 0, cus = 0, per_cu = 0;
        hipGetDevice(&dev); hipDeviceGetAttribute(&cus, hipDeviceAttributeMultiprocessorCount, dev);
        if (hipFuncSetAttribute((const void*)fwd_megakernel<0, 4>, hipFuncAttributeMaxDynamicSharedMemorySize, LDS_BYTES) != hipSuccess) fprintf(stderr, "kernel_launch: hipFuncSetAttribute failed\n");
        if (hipOccupancyMaxActiveBlocksPerMultiprocessor(&per_cu, (const void*)fwd_megakernel<0, 4>, 512, LDS_BYTES) != hipSuccess || per_cu < 1) { fprintf(stderr, "kernel_launch: occupancy query says %d\n", per_cu); per_cu = 1; }
        (void)hipGetLastError();
        if (N_LAUNCHES == 1 && cus * per_cu < NP) { fprintf(stderr, "kernel_launch: needs %d co-resident workgroups, device holds %d\n", NP, cus * per_cu); }
        grid = NP;
    }
    if (grid < 0) return;
    if (hipMemsetAsync((char*)d_ws + WS_RSTD0 + 512 * 1024, 0, 16384, stream) != hipSuccess) fprintf(stderr, "kernel_launch: hipMemsetAsync failed\n");
    Args a{};
    for (int i = 0; i < 18; ++i) a.in[i] = (const float*)d_in[i];
    a.out = (float*)d_out; a.ws = (unsigned char*)d_ws;
    hipError_t e = hipSuccess;
#if N_LAUNCHES == 1
    void* kargs[] = {&a};
    e = hipLaunchCooperativeKernel((const void*)fwd_megakernel<0, 4>, dim3(grid), dim3(512), kargs, LDS_BYTES, stream);
#else
    hipFuncSetAttribute((const void*)fwd_megakernel<0, 1>, hipFuncAttributeMaxDynamicSharedMemorySize, LDS_BYTES); hipFuncSetAttribute((const void*)fwd_megakernel<1, 2>, hipFuncAttributeMaxDynamicSharedMemorySize, LDS_BYTES);
    hipFuncSetAttribute((const void*)fwd_megakernel<2, 3>, hipFuncAttributeMaxDynamicSharedMemorySize, LDS_BYTES); hipFuncSetAttribute((const void*)fwd_megakernel<3, 4>, hipFuncAttributeMaxDynamicSharedMemorySize, LDS_BYTES);
    for (int r_ = 0; r_ < N_LAUNCHES - 3; ++r_) hipLaunchKernelGGL((fwd_megakernel<0, 1>), dim3(grid), dim3(512), LDS_BYTES, stream, a);
    hipLaunchKernelGGL((fwd_megakernel<1, 2>), dim3(grid), dim3(512), LDS_BYTES, stream, a);
    hipLaunchKernelGGL((fwd_megakernel<2, 3>), dim3(grid), dim3(512), LDS_BYTES, stream, a); hipLaunchKernelGGL((fwd_megakernel<3, 4>), dim3(grid), dim3(512), LDS_BYTES, stream, a);
    e = hipPeekAtLastError();
#endif
    if (e != hipSuccess) fprintf(stderr, "kernel_launch: cooperative launch failed: %s (grid %d)\n", hipGetErrorString(e), grid);
}
```

```cpp
#include <hip/hip_runtime.h>
#include <hip/hip_cooperative_groups.h>
#include <cstdio>
#include <cstdint>
#include <cmath>
namespace cg = cooperative_groups;

#ifndef N_LAUNCHES
#define N_LAUNCHES 1
#endif
#ifndef REP_P0
#define REP_P0 1
#endif
#ifndef REP_P1
#define REP_P1 1
#endif
#ifndef REP_P2
#define REP_P2 1
#endif
#ifndef REP_P5
#define REP_P5 1
#endif
#ifndef PROBE_T
#define PROBE_T 0
#endif
#ifndef DBG_NO_SB
#define DBG_NO_SB 0
#endif
#ifndef DBG_NO_MOBA
#define DBG_NO_MOBA 0
#endif

namespace pg8 {
#define PG8_LAS __attribute__((address_space(3)))
typedef unsigned short bf16_t;
typedef short bf16x8 __attribute__((ext_vector_type(8)));
typedef float f32x4 __attribute__((ext_vector_type(4)));
typedef unsigned u32x4 __attribute__((ext_vector_type(4)));
typedef unsigned u32x2 __attribute__((ext_vector_type(2)));
constexpr int BM = 256, BK = 64, HALF = 128, HTB = HALF * BK * 2  , STAGE_BYTES = 8 * HTB;

__host__ __device__ __forceinline__ int lds_byte(int r, int c) { const int st = (r >> 4) * 2 + (c >> 5), rr = r & 15, cc = c & 31, ob = rr * 64 + cc * 2; return st * 1024 + (ob ^ (((ob >> 9) & 1) << 5)); }
__host__ __device__ __forceinline__ void stage_rc(int b, int& R, int& C) { const int st = b / 1024, sb = b % 1024, swz = sb ^ (((sb >> 9) & 1) << 5); R = (st >> 1) * 16 + swz / 64; C = (st & 1) * 32 + (swz % 64) / 2; }
__host__ __device__ __forceinline__ int perm32(int rho) { const int n = rho >> 4, i = rho & 15; return 8 * (i >> 2) + 4 * n + (i & 3); }

struct Unit { int pm, pn, ka; };
struct Gemm { const bf16_t* A; const bf16_t* Bt; int lda, K; };

typedef float f32x2_t __attribute__((ext_vector_type(2))); typedef __bf16 bf16x2_t __attribute__((ext_vector_type(2)));
__device__ __forceinline__ unsigned cvt_pk_bf16(float lo, float hi) { f32x2_t v = {lo, hi}; bf16x2_t b = __builtin_convertvector(v, bf16x2_t); return __builtin_bit_cast(unsigned, b); }
__device__ __forceinline__ float bflo(unsigned w) { return __uint_as_float(w << 16); }
__device__ __forceinline__ float bfhi(unsigned w) { return __uint_as_float(w & 0xffff0000u); }
__device__ __forceinline__ float sigm(float x) { return __builtin_amdgcn_rcpf(1.f + __expf(-x)); }
__device__ __forceinline__ u32x4 pack8(f32x4 a, f32x4 b) { u32x4 w; w.x = cvt_pk_bf16(a[0], a[1]); w.y = cvt_pk_bf16(a[2], a[3]); w.z = cvt_pk_bf16(b[0], b[1]); w.w = cvt_pk_bf16(b[2], b[3]); return w; }

template <class Epi, class Sched, bool ALIGN_EPI = false, bool SP2 = false>
__device__ __forceinline__ void gemm_phase(PG8_LAS unsigned char* lds, const Gemm g, const Sched& S, const Epi& E, const int wave_s) {
    int tid_; asm volatile("v_mbcnt_lo_u32_b32 %0, -1, 0\n\tv_mbcnt_hi_u32_b32 %0, -1, %0" : "=v"(tid_)); tid_ += 64 * wave_s;
    const int tid = tid_, wid = __builtin_amdgcn_readfirstlane(tid >> 6), lane = tid & 63, wr = wid >> 2, wc = wid & 3, fr = lane & 15, fq = lane >> 4;
    const int K = g.K, nt = K / BK;
    unsigned voffA[2], voffB[2];
#pragma unroll
    for (int i = 0; i < 2; ++i) { int R, C; stage_rc(tid * 16 + i * 8192, R, C); const int Rb = Epi::PERM ? ((R & ~31) + perm32(R & 31)) : R;
        voffA[i] = (unsigned)(R * g.lda + C) * 2u; voffB[i] = (unsigned)(Rb * K + C) * 2u; }
    const size_t kstep = (size_t)(BK * 2);
    const size_t hstepA = (size_t)HALF * g.lda * 2, hstepB = (size_t)HALF * K * 2;
    const size_t tstepA = 2 * hstepA, tstepB = 2 * hstepB;
    const unsigned ldsw = (unsigned)wid * 1024u;
    const int aoff = lds_byte(wr * 64 + fr, fq * 8), boff = lds_byte(wc * 32 + fr, fq * 8);
#define PG8_SA(b, h) (((b) * 2 + (h)) * HTB)
#define PG8_SB(b, h) ((4 + (b) * 2 + (h)) * HTB)
#define PG8_STAGE(bufoff, gbase, voff) do { _Pragma("unroll") for (int _i = 0; _i < 2; ++_i) \
        __builtin_amdgcn_global_load_lds((const unsigned*)((const char*)(gbase) + (voff)[_i]), (PG8_LAS unsigned*)(lds + (bufoff) + ldsw + _i * 8192), 16, 0, 0); } while (0)
#define PG8_LDA(dst, b, h) do { _Pragma("unroll") for (int m = 0; m < 4; ++m) _Pragma("unroll") for (int k = 0; k < 2; ++k) dst[m][k] = *(const PG8_LAS bf16x8*)(lds + PG8_SA(b, h) + aoff + m * 2048 + k * 1024); } while (0)
#define PG8_LDB(dst, b, h) do { _Pragma("unroll") for (int n = 0; n < 2; ++n) _Pragma("unroll") for (int k = 0; k < 2; ++k) dst[n][k] = *(const PG8_LAS bf16x8*)(lds + PG8_SB(b, h) + boff + n * 2048 + k * 1024); } while (0)
#define PG8_MMA(ai, bj, At, Bt) do { __builtin_amdgcn_s_setprio(1); _Pragma("unroll") for (int m = 0; m < 4; ++m) _Pragma("unroll") for (int n = 0; n < 2; ++n) _Pragma("unroll") for (int k = 0; k < 2; ++k) \
        acc[ai][bj][m][n] = __builtin_amdgcn_mfma_f32_16x16x32_bf16(Bt[n][k], At[m][k], acc[ai][bj][m][n], 0, 0, 0); __builtin_amdgcn_s_setprio(0); } while (0)
#define PG8_WAIT_V(n) asm volatile("s_waitcnt vmcnt(" #n ")" ::: "memory")
#define PG8_WAIT_L(n) asm volatile("s_waitcnt lgkmcnt(" #n ")" ::: "memory")
#define PG8_BAR __builtin_amdgcn_s_barrier()
#define PG8_SCHED __builtin_amdgcn_sched_barrier(0)
    Unit cur, nxt; int ui = 0;
    if (!S.next(0, cur)) return;
    f32x4 acc[2][2][4][2];
#pragma unroll
    for (int a = 0; a < 2; ++a)
#pragma unroll
        for (int b = 0; b < 2; ++b)
#pragma unroll
            for (int m = 0; m < 4; ++m)
#pragma unroll
                for (int n = 0; n < 2; ++n) acc[a][b][m][n] = (f32x4){0.f, 0.f, 0.f, 0.f};
    bf16x8 At[4][2], B0[2][2], B1[2][2];
    const char* cA = (const char*)g.A + (size_t)cur.pm * tstepA + (size_t)cur.ka * 2; const char* cB = (const char*)g.Bt + (size_t)cur.pn * tstepB;
    if constexpr (SP2) {
        PG8_STAGE(PG8_SB(0, 0), cB, voffB); PG8_STAGE(PG8_SB(0, 1), cB + hstepB, voffB); PG8_STAGE(PG8_SA(0, 0), cA, voffA); PG8_STAGE(PG8_SA(0, 1), cA + hstepA, voffA);
        if (wr == 1) PG8_BAR;
        PG8_WAIT_V(2); PG8_BAR;
        PG8_STAGE(PG8_SB(1, 0), cB + kstep, voffB); PG8_STAGE(PG8_SA(1, 0), cA + kstep, voffA); PG8_STAGE(PG8_SB(1, 1), cB + hstepB + kstep, voffB);
        PG8_WAIT_V(6); PG8_BAR;
    } else {
        PG8_STAGE(PG8_SB(0, 0), cB, voffB); PG8_STAGE(PG8_SA(0, 0), cA, voffA); PG8_STAGE(PG8_SB(0, 1), cB + hstepB, voffB); PG8_STAGE(PG8_SA(0, 1), cA + hstepA, voffA);
        if (wr == 1) PG8_BAR;
        PG8_WAIT_V(4); PG8_BAR;
        PG8_STAGE(PG8_SB(1, 0), cB + kstep, voffB); PG8_STAGE(PG8_SA(1, 0), cA + kstep, voffA); PG8_STAGE(PG8_SB(1, 1), cB + hstepB + kstep, voffB);
        PG8_WAIT_V(6); PG8_BAR;
    }
    for (;;) {
        const bool has_next = S.next(ui + 1, nxt);
        const char* nA = has_next ? (const char*)g.A + (size_t)nxt.pm * tstepA + (size_t)nxt.ka * 2 : cA; const char* nB = has_next ? (const char*)g.Bt + (size_t)nxt.pn * tstepB : cB;
        for (int t = 0; t < nt; t += 2) {
            const bool last = (t == nt - 2);
            const char* a1 = cA + (size_t)(t + 1) * kstep;
            const char* a2 = last ? nA : cA + (size_t)(t + 2) * kstep; const char* b2 = last ? nB : cB + (size_t)(t + 2) * kstep;
            const char* a3 = a2 + kstep; const char* b3 = b2 + kstep;
            if constexpr (SP2) {
            PG8_LDB(B0, 0, 0); PG8_LDB(B1, 0, 1); PG8_SCHED; PG8_LDA(At, 0, 0); PG8_STAGE(PG8_SA(1, 1), a1 + hstepA, voffA);
            PG8_WAIT_V(8); PG8_WAIT_L(0); PG8_BAR; PG8_MMA(0, 0, At, B0); PG8_MMA(0, 1, At, B1); PG8_BAR; PG8_SCHED;
            PG8_LDA(At, 0, 1); PG8_STAGE(PG8_SB(0, 0), b2, voffB); PG8_STAGE(PG8_SB(0, 1), b2 + hstepB, voffB); PG8_STAGE(PG8_SA(0, 0), a2, voffA);
            PG8_WAIT_V(8); PG8_WAIT_L(0); PG8_BAR; PG8_MMA(1, 0, At, B0); PG8_MMA(1, 1, At, B1); PG8_BAR; PG8_SCHED;
            PG8_LDB(B0, 1, 0); PG8_LDB(B1, 1, 1); PG8_SCHED; PG8_LDA(At, 1, 0); PG8_STAGE(PG8_SA(0, 1), a2 + hstepA, voffA);
            PG8_WAIT_V(8); PG8_WAIT_L(0); PG8_BAR; PG8_MMA(0, 0, At, B0); PG8_MMA(0, 1, At, B1); PG8_BAR; PG8_SCHED;
            PG8_LDA(At, 1, 1); PG8_STAGE(PG8_SB(1, 0), b3, voffB); PG8_STAGE(PG8_SB(1, 1), b3 + hstepB, voffB); PG8_STAGE(PG8_SA(1, 0), a3, voffA);
            PG8_WAIT_V(8); PG8_WAIT_L(0); PG8_BAR; PG8_MMA(1, 0, At, B0); PG8_MMA(1, 1, At, B1); PG8_BAR; PG8_SCHED;
            } else {
            PG8_LDB(B0, 0, 0); PG8_SCHED; PG8_LDA(At, 0, 0); PG8_STAGE(PG8_SA(1, 1), a1 + hstepA, voffA);
            PG8_WAIT_L(8); PG8_BAR; PG8_WAIT_L(0); PG8_MMA(0, 0, At, B0); PG8_BAR; PG8_SCHED;
            PG8_LDB(B1, 0, 1); PG8_STAGE(PG8_SB(0, 0), b2, voffB);
            PG8_BAR; PG8_WAIT_L(0); PG8_MMA(0, 1, At, B1); PG8_BAR;
            PG8_LDA(At, 0, 1); PG8_STAGE(PG8_SA(0, 0), a2, voffA);
            PG8_BAR; PG8_WAIT_L(0); PG8_MMA(1, 0, At, B0); PG8_BAR; PG8_SCHED;
            PG8_STAGE(PG8_SB(0, 1), b2 + hstepB, voffB);
            PG8_WAIT_V(6); PG8_BAR; PG8_MMA(1, 1, At, B1); PG8_BAR;
            PG8_LDB(B0, 1, 0); PG8_SCHED; PG8_LDA(At, 1, 0); PG8_STAGE(PG8_SA(0, 1), a2 + hstepA, voffA);
            PG8_WAIT_L(8); PG8_BAR; PG8_WAIT_L(0); PG8_MMA(0, 0, At, B0); PG8_BAR; PG8_SCHED;
            PG8_LDB(B1, 1, 1); PG8_STAGE(PG8_SB(1, 0), b3, voffB);
            PG8_BAR; PG8_WAIT_L(0); PG8_MMA(0, 1, At, B1); PG8_BAR;
            PG8_LDA(At, 1, 1); PG8_STAGE(PG8_SA(1, 0), a3, voffA);
            PG8_BAR; PG8_WAIT_L(0); PG8_MMA(1, 0, At, B0); PG8_BAR; PG8_SCHED;
            PG8_STAGE(PG8_SB(1, 1), b3 + hstepB, voffB);
            PG8_WAIT_V(6); PG8_BAR; PG8_MMA(1, 1, At, B1); PG8_BAR;
            }
        }
        if constexpr (ALIGN_EPI) { if (wr == 0) PG8_BAR; }
        const bool keep = E(acc, cur, wr, wc, fr, fq);
        if (!has_next) break;
        if (!keep) {
#pragma unroll
        for (int a = 0; a < 2; ++a)
#pragma unroll
            for (int b = 0; b < 2; ++b)
#pragma unroll
                for (int m = 0; m < 4; ++m)
#pragma unroll
                    for (int n = 0; n < 2; ++n) acc[a][b][m][n] = (f32x4){0.f, 0.f, 0.f, 0.f};
        }
        cur = nxt; cA = nA; cB = nB; ++ui;
        if constexpr (ALIGN_EPI) { if (wr == 1) PG8_BAR; }
    }
    PG8_WAIT_V(0);
    if constexpr (!ALIGN_EPI) { if (wr == 0) PG8_BAR; }
    PG8_BAR;
#undef PG8_SA
#undef PG8_SB
#undef PG8_STAGE
#undef PG8_LDA
#undef PG8_LDB
#undef PG8_MMA
#undef PG8_WAIT_V
#undef PG8_WAIT_L
#undef PG8_BAR
#undef PG8_SCHED
}
}

using pg8::bf16_t; using pg8::f32x4; using pg8::u32x4; using pg8::u32x2; using pg8::Unit; using pg8::cvt_pk_bf16; using pg8::bflo; using pg8::bfhi; using pg8::sigm; using pg8::pack8;
#define LAS __attribute__((address_space(3)))

constexpr int NB = 32, SEQ = 2048, DM = 1024, MTOK = NB * SEQ, NP = MTOK / 256;
constexpr int FFH = 2816, PLE = 256;
constexpr float EPS = 1e-6f, LOG2E = 1.4426950408889634f;

constexpr size_t MiB = 1u << 20;
constexpr size_t WS_RSTD0 = 0, WS_KPART = 1 * MiB;
constexpr size_t WS_W1T = 2 * MiB, WS_WVT = 10 * MiB, WS_W3T = 12 * MiB, WS_WOT = 14 * MiB, WS_WGUT = 16 * MiB, WS_WDT = 27 * MiB, WS_WPGT = 33 * MiB, WS_WPPT = 35 * MiB;
constexpr size_t WS_SSQ1 = 36 * MiB, WS_SSQ2 = 40 * MiB, WS_SSQ3 = 44 * MiB;
constexpr size_t WS_PB = 48 * MiB;
constexpr size_t WS_XB = 80 * MiB;
constexpr size_t WS_QK = 208 * MiB;
constexpr size_t WS_VT = 464 * MiB;
constexpr size_t WS_H = 208 * MiB;
constexpr size_t WS_GT = 592 * MiB;
constexpr size_t WS_A2 = 848 * MiB;
constexpr size_t WS_END = 976 * MiB;
static_assert(WS_H + (size_t)MTOK * FFH * 2 <= WS_GT && WS_VT + (size_t)MTOK * 512 * 2 * 2 <= WS_GT, "ws map");

constexpr int RING_BYTES = 131072, RS_OFF = RING_BYTES, LDS_BYTES = 152 * 1024;

struct PanelSched {
    int pm, n, mode;
    __device__ __forceinline__ bool next(int i, Unit& u) const {
        if (i >= n) return false;
        if (mode == 0) { u.pm = pm; u.pn = i; u.ka = 0; }
        else if (mode == 2) { u.pm = i; u.pn = pm; u.ka = 0; }
        else { const int pass = i & 1; u.pm = pm; u.pn = (i >> 1) + 4 * pass; u.ka = 512 * pass; }
        return true;
    }
};

struct XcdOrder {
    int nM, nN, nwg, G, c, W;
    __device__ __forceinline__ void init(int nM_, int nN_, int G_, int c_, int W_ = 8) { nM = nM_; nN = nN_; nwg = nM * nN; G = G_; c = c_; W = W_; }
    __device__ __forceinline__ bool next(int i, Unit& u) const {
        const long L = (long)i * G + c; if (L >= nwg) return false;
        int wgid = (int)L; { const int q = nwg / 8, r = nwg % 8, xcd = wgid % 8, off = wgid / 8; wgid = (xcd < r ? xcd * (q + 1) : r * (q + 1) + (xcd - r) * q) + off; }
        const int nig = W * nN, gid = wgid / nig, fm = gid * W, gsz = (nM - fm) < W ? (nM - fm) : W;
        u.pm = fm + ((wgid % nig) % gsz); u.pn = (wgid % nig) / gsz; u.ka = 0; return true;
    }
};

struct Epi1 {
    static constexpr bool PERM = true;
    const float* rstd0; const float* bgate; bf16_t* QK; bf16_t* Gt; float* kpart;
    __device__ __forceinline__ bool operator()(f32x4 (&acc)[2][2][4][2], const Unit& u, int wr, int wc, int fr_, int fq_) const {
        int fr = fr_, fq = fq_; asm volatile("" : "+v"(fr), "+v"(fq));
        const int rowl = wr * 64 + fr, row0 = u.pm * 256 + rowl, lc0 = wc * 32 + 8 * fq, pn = u.pn;
        float rs[2][4];
#pragma unroll
        for (int ai = 0; ai < 2; ++ai)
#pragma unroll
            for (int m = 0; m < 4; ++m) rs[ai][m] = rstd0[row0 + ai * 128 + m * 16];
        if (pn < 8) {
            const int cb = pn * 256 + lc0;
#pragma unroll
            for (int ai = 0; ai < 2; ++ai)
#pragma unroll
                for (int m = 0; m < 4; ++m) {
                    bf16_t* rowp = QK + (size_t)(row0 + ai * 128 + m * 16) * 2048 + cb; const float r = rs[ai][m];
#pragma unroll
                    for (int bj = 0; bj < 2; ++bj) *(u32x4*)(rowp + bj * 128) = pack8(acc[ai][bj][m][0] * r, acc[ai][bj][m][1] * r);
                }
            if (pn >= 6) {
#pragma unroll
                for (int bj = 0; bj < 2; ++bj)
#pragma unroll
                    for (int n = 0; n < 2; ++n)
#pragma unroll
                        for (int j = 0; j < 4; ++j) {
                            float s = 0.f;
#pragma unroll
                            for (int ai = 0; ai < 2; ++ai)
#pragma unroll
                                for (int m = 0; m < 4; ++m) s += acc[ai][bj][m][n][j] * rs[ai][m];
                            s += __shfl_xor(s, 1); s += __shfl_xor(s, 2); s += __shfl_xor(s, 4); s += __shfl_xor(s, 8);
                            if (fr == 0) kpart[(size_t)(u.pm * 2 + wr) * 512 + (pn & 1) * 256 + bj * 128 + lc0 + 4 * n + j] = s;
                        }
            }
        } else {
            const int gc = (pn - 8) * 256 + lc0;
            f32x4 bv[2][2];
#pragma unroll
            for (int bj = 0; bj < 2; ++bj)
#pragma unroll
                for (int n = 0; n < 2; ++n) bv[bj][n] = *(const f32x4*)(bgate + gc + bj * 128 + 4 * n);
#pragma unroll
            for (int ai = 0; ai < 2; ++ai)
#pragma unroll
                for (int m = 0; m < 4; ++m) {
                    bf16_t* rowp = Gt + (size_t)(row0 + ai * 128 + m * 16) * 2048 + gc; const float r = rs[ai][m];
#pragma unroll
                    for (int bj = 0; bj < 2; ++bj) {
                        f32x4 v0 = acc[ai][bj][m][0] * r + bv[bj][0], v1 = acc[ai][bj][m][1] * r + bv[bj][1];
#pragma unroll
                        for (int j = 0; j < 4; ++j) { v0[j] = sigm(v0[j]); v1[j] = sigm(v1[j]); }
                        *(u32x4*)(rowp + bj * 128) = pack8(v0, v1);
                    }
                }
        }
        return false;
    }
};

struct EpiVT {
    static constexpr bool PERM = true;
    const float* rstd0; bf16_t* VT;
    __device__ __forceinline__ bool operator()(f32x4 (&acc)[2][2][4][2], const Unit& u, int wr, int wc, int fr_, int fq_) const {
        int fr = fr_, fq = fq_; asm volatile("" : "+v"(fr), "+v"(fq));
        const int b = u.pn >> 3, t0 = (u.pn & 7) * 256 + wc * 32 + 8 * fq;
        f32x4 rv[2][2];
#pragma unroll
        for (int bj = 0; bj < 2; ++bj)
#pragma unroll
            for (int n = 0; n < 2; ++n) rv[bj][n] = *(const f32x4*)(rstd0 + (size_t)b * SEQ + t0 + bj * 128 + 4 * n);
#pragma unroll
        for (int ai = 0; ai < 2; ++ai)
#pragma unroll
            for (int m = 0; m < 4; ++m) {
                const int vr = u.pm * 256 + ai * 128 + wr * 64 + m * 16 + fr;
                bf16_t* rowp = VT + ((size_t)(((vr >> 9) * 32 + b) * 512 + (vr & 511))) * 2048 + t0;
#pragma unroll
                for (int bj = 0; bj < 2; ++bj) *(u32x4*)(rowp + bj * 128) = pack8(acc[ai][bj][m][0] * rv[bj][0], acc[ai][bj][m][1] * rv[bj][1]);
            }
        return false;
    }
};

struct Epi3 {
    static constexpr bool PERM = true;
    const bf16_t* Gt; bf16_t* mix;
    __device__ __forceinline__ bool operator()(f32x4 (&acc)[2][2][4][2], const Unit& u, int wr, int wc, int fr_, int fq_) const {
        int fr = fr_, fq = fq_; asm volatile("" : "+v"(fr), "+v"(fq));
        const int pass = u.pn >> 2, nc = (u.pn & 3) * 256 + wc * 32 + 8 * fq, row0 = u.pm * 256 + wr * 64 + fr;
#pragma unroll
        for (int ai = 0; ai < 2; ++ai)
#pragma unroll
            for (int m = 0; m < 4; ++m) {
                const size_t row = (size_t)(row0 + ai * 128 + m * 16); const bf16_t* gp = Gt + row * 2048 + nc + pass * 1024;
#pragma unroll
                for (int bj = 0; bj < 2; ++bj) {
                    const u32x4 gg = *(const u32x4*)(gp + bj * 128);
                    const f32x4 g0 = {bflo(gg.x), bfhi(gg.x), bflo(gg.y), bfhi(gg.y)}, g1 = {bflo(gg.z), bfhi(gg.z), bflo(gg.w), bfhi(gg.w)};
                    f32x4 v0 = acc[ai][bj][m][0] * g0, v1 = acc[ai][bj][m][1] * g1;
                    u32x4* mp = (u32x4*)(mix + row * 1024 + nc + bj * 128);
                    if (pass == 1) { const u32x4 t = *mp;
                        v0 += (f32x4){bflo(t.x), bfhi(t.x), bflo(t.y), bfhi(t.y)}; v1 += (f32x4){bflo(t.z), bfhi(t.z), bflo(t.w), bfhi(t.w)}; }
                    *mp = pack8(v0, v1);
                }
            }
        return false;
    }
};

template <int MODE> struct EpiRes {
    static constexpr bool PERM = true;
    const float* base; const bf16_t* baseb; bf16_t* xb; float* ssq; const bf16_t* PP; const LAS float* rs;
    __device__ __forceinline__ bool operator()(f32x4 (&acc)[2][2][4][2], const Unit& u, int wr, int wc, int fr_, int fq_) const {
        int fr = fr_, fq = fq_; asm volatile("" : "+v"(fr), "+v"(fq));
        const int rl = wr * 64 + fr, c0 = u.pn * 256 + wc * 32 + 8 * fq;
#pragma unroll
        for (int ai = 0; ai < 2; ++ai)
#pragma unroll
            for (int m = 0; m < 4; ++m) {
                const int rloc = ai * 128 + m * 16 + rl; const size_t row = (size_t)u.pm * 256 + rloc; float ss = 0.f; const float r = MODE == 1 ? rs[rloc] : 0.f;
#pragma unroll
                for (int bj = 0; bj < 2; ++bj) {
                    const size_t off = row * 1024 + c0 + bj * 128; f32x4 b0, b1, v0, v1;
                    if (MODE == 0) { b0 = *(const f32x4*)(base + off); b1 = *(const f32x4*)(base + off + 4); }
                    else { const u32x4 t = *(const u32x4*)(baseb + off); b0 = (f32x4){bflo(t.x), bfhi(t.x), bflo(t.y), bfhi(t.y)}; b1 = (f32x4){bflo(t.z), bfhi(t.z), bflo(t.w), bfhi(t.w)}; }
                    if (MODE != 1) { v0 = b0 + acc[ai][bj][m][0]; v1 = b1 + acc[ai][bj][m][1]; }
                    else { const u32x4 t = *(const u32x4*)(PP + off + row * 1024);
                        const f32x4 p0 = {bflo(t.x), bfhi(t.x), bflo(t.y), bfhi(t.y)}, p1 = {bflo(t.z), bfhi(t.z), bflo(t.w), bfhi(t.w)};
                        f32x4 a0 = acc[ai][bj][m][0] * r, a1 = acc[ai][bj][m][1] * r;
#pragma unroll
                        for (int j = 0; j < 4; ++j) { a0[j] = sigm(a0[j]); a1[j] = sigm(a1[j]); }
                        v0 = b0 + a0 * p0; v1 = b1 + a1 * p1; }
                    ss += ((v0[0] * v0[0] + v0[1] * v0[1]) + (v0[2] * v0[2] + v0[3] * v0[3])) + ((v1[0] * v1[0] + v1[1] * v1[1]) + (v1[2] * v1[2] + v1[3] * v1[3]));
                    *(u32x4*)(xb + off) = pack8(v0, v1);
                }
                ss += __shfl_xor(ss, 16); ss += __shfl_xor(ss, 32);
                if (fq == 0) ssq[row * 16 + u.pn * 4 + wc] = ss;
            }
        return false;
    }
};

struct Epi5 {
    static constexpr bool PERM = true;
    bf16_t* H; const LAS float* rs;
    __device__ __forceinline__ bool operator()(f32x4 (&acc)[2][2][4][2], const Unit& u, int wr, int wc, int fr_, int fq_) const {
        int fr = fr_, fq = fq_; asm volatile("" : "+v"(fr), "+v"(fq));
        const int rl = wr * 64 + fr, hc = u.pn * 128 + wc * 32 + 8 * fq;
#pragma unroll
        for (int ai = 0; ai < 2; ++ai)
#pragma unroll
            for (int m = 0; m < 4; ++m) {
                const int rloc = ai * 128 + m * 16 + rl; const size_t row = (size_t)u.pm * 256 + rloc; const float r = rs[rloc];
                f32x4 h[2];
#pragma unroll
                for (int n = 0; n < 2; ++n) { const f32x4 g = acc[ai][0][m][n] * r, up = acc[ai][1][m][n] * r;
#pragma unroll
                    for (int j = 0; j < 4; ++j) h[n][j] = g[j] * sigm(g[j]) * up[j]; }
                *(u32x4*)(H + row * FFH + hc) = pack8(h[0], h[1]);
            }
        return false;
    }
};

struct EpiPP {
    static constexpr bool PERM = true;
    bf16_t* out;
    __device__ __forceinline__ bool operator()(f32x4 (&acc)[2][2][4][2], const Unit& u, int wr, int wc, int fr_, int fq_) const {
        int fr = fr_, fq = fq_; asm volatile("" : "+v"(fr), "+v"(fq));
        const int rl = wr * 64 + fr, c0 = u.pn * 256 + wc * 32 + 8 * fq;
#pragma unroll
        for (int ai = 0; ai < 2; ++ai)
#pragma unroll
            for (int m = 0; m < 4; ++m) { const size_t row = (size_t)u.pm * 256 + ai * 128 + m * 16 + rl;
#pragma unroll
                for (int bj = 0; bj < 2; ++bj) *(u32x4*)(out + row * 2048 + c0 + bj * 128) = pack8(acc[ai][bj][m][0], acc[ai][bj][m][1]); }
        return false;
    }
};

namespace att {
typedef short bf16x8 __attribute__((ext_vector_type(8)));
typedef float f32x16 __attribute__((ext_vector_type(16)));
#define MFMA32(a, b, c) __builtin_amdgcn_mfma_f32_32x32x16_bf16((a), (b), (c), 0, 0, 0)
__device__ __forceinline__ int swap23(int r) { return (r & 0x13) | ((r & 4) << 1) | ((r & 8) >> 1); }
__device__ __forceinline__ float bf2f(short b) { return __uint_as_float(((unsigned)(unsigned short)b) << 16); }
__device__ __forceinline__ bf16x8 pack8f(const float* p) {
    u32x4 w; w.x = cvt_pk_bf16(p[0], p[1]); w.y = cvt_pk_bf16(p[2], p[3]); w.z = cvt_pk_bf16(p[4], p[5]); w.w = cvt_pk_bf16(p[6], p[7]);
    return __builtin_bit_cast(bf16x8, w);
}
struct Frag { bf16x8 k[4]; bf16x8 v[2][2]; };
__device__ __forceinline__ void load_tile(Frag& f, const bf16_t* kp, const bf16_t* vp) {
#pragma unroll
    for (int s = 0; s < 4; ++s) f.k[s] = *(const bf16x8*)(kp + 16 * s);
#pragma unroll
    for (int dt = 0; dt < 2; ++dt)
#pragma unroll
        for (int g = 0; g < 2; ++g) f.v[dt][g] = *(const bf16x8*)(vp + (size_t)dt * 32 * 2048 + 16 * g);
}
__device__ __forceinline__ void store_o(bf16_t* op, const f32x16& o0, const f32x16& o1, float inv) {
    float t[8];
#pragma unroll
    for (int g = 0; g < 2; ++g) {
#pragma unroll
        for (int e = 0; e < 8; ++e) t[e] = o0[8 * g + e] * inv;
        *(bf16x8*)(op + 16 * g) = pack8f(t);
#pragma unroll
        for (int e = 0; e < 8; ++e) t[e] = o1[8 * g + e] * inv;
        *(bf16x8*)(op + 32 + 16 * g) = pack8f(t);
    }
}

__device__ __forceinline__ void moba_wave(int b, int h, int c, int sub, const bf16_t* QK, const bf16_t* VT, const float* kpart, bf16_t* O,
                                          const LAS float* lut, LAS float* kb, int lane) {
    const int ql = lane & 31, hi = lane >> 5;
    const int tq = c * 256 + sub * 32 + ql;
    const size_t qrow = (size_t)b * SEQ + tq;
    { float ka[7], kc[7];
#pragma unroll
      for (int j = 0; j < 7; ++j) { const float* kp = kpart + (size_t)((b * 8 + (j < c ? j : 0)) * 2) * 512 + h * 64 + lane; ka[j] = kp[0]; kc[j] = kp[512]; }
#pragma unroll
      for (int j = 0; j < 7; ++j) if (j < c) kb[j * 64 + lane] = (ka[j] + kc[j]) * (1.f / 256.f); }
    asm volatile("s_waitcnt lgkmcnt(0)" ::: "memory");
    bf16x8 qf[4];
    { const bf16_t* qp = QK + qrow * 2048 + 1024 + h * 64 + 8 * hi;
#pragma unroll
      for (int s = 0; s < 4; ++s) qf[s] = *(const bf16x8*)(qp + 16 * s); }
    unsigned sel;
    if (c <= 3) sel = (1u << c) - 1u;
    else {
        float g[7];
#pragma unroll
        for (int j = 0; j < 7; ++j) {
            float a = -INFINITY;
            if (j < c) {
                a = 0.f;
#pragma unroll
                for (int s = 0; s < 4; ++s)
#pragma unroll
                    for (int e = 0; e < 8; ++e) a += bf2f(qf[s][e]) * kb[j * 64 + 16 * s + 8 * hi + e];
                a += __shfl_xor(a, 32);
            }
            g[j] = a;
        }
        sel = 0u;
#pragma unroll
        for (int k = 0; k < 3; ++k) {
            float best = -INFINITY; int bi = 0;
#pragma unroll
            for (int j = 0; j < 7; ++j) { const bool t = !((sel >> j) & 1u) && g[j] > best; best = t ? g[j] : best; bi = t ? j : bi; }
            sel |= 1u << bi;
        }
    }
    unsigned rem = 0u;
    for (int j = 0; j < c; ++j) if (__ballot((sel >> j) & 1u) != 0ull) rem |= 1u << j;
    rem = __builtin_amdgcn_readfirstlane(rem);

    const float c2 = 0.125f * LOG2E, bfar = lut[127];
    f32x16 o0, o1;
#pragma unroll
    for (int r = 0; r < 16; ++r) { o0[r] = 0.f; o1[r] = 0.f; }
    float m_run = -INFINITY, l_run = 0.f;
    const bf16_t* kbase = QK + (size_t)b * SEQ * 2048 + 1536 + h * 64 + 8 * hi + (size_t)swap23(ql) * 2048;
    const bf16_t* vbase = VT + ((size_t)((32 + b) * 8 + h) * 64 + swap23(ql)) * 2048 + 8 * hi;
    int tok = c * 256; bool in_own = true;
    Frag cur, nxt;
    load_tile(cur, kbase + (size_t)tok * 2048, vbase + tok);
    for (;;) {
        int tokn = tok; bool has_next = true;
        if (in_own && tok < c * 256 + sub * 32) tokn = tok + 32;
        else if (!in_own && (tok & 255) != 224) tokn = tok + 32;
        else if (rem) { const int j = __builtin_ctz(rem); rem &= rem - 1u; tokn = j * 256; }
        else has_next = false;
        if (has_next) load_tile(nxt, kbase + (size_t)tokn * 2048, vbase + tokn);
        {
            const int jb = tok >> 8; const bool own = (jb == c);
            f32x16 S;
#pragma unroll
            for (int r = 0; r < 16; ++r) S[r] = 0.f;
#pragma unroll
            for (int s = 0; s < 4; ++s) S = MFMA32(cur.k[s], qf[s], S);
            asm volatile("" :: "v"(cur.k[0]), "v"(cur.k[1]), "v"(cur.k[2]), "v"(cur.k[3]));
            const int dist0 = tq - tok - 8 * hi;
            const bool lanesel = own || ((sel >> jb) & 1u);
            float x[16];
            if (jb + 1 < c) {
#pragma unroll
                for (int r = 0; r < 16; ++r) x[r] = lanesel ? (S[r] * c2 + bfar) : -INFINITY;
            } else {
#pragma unroll
                for (int r = 0; r < 16; ++r) {
                    const int dist = dist0 - ((r & 7) + 16 * (r >> 3));
                    const int di = dist < 0 ? 0 : (dist > 127 ? 127 : dist);
                    const float v = S[r] * c2 + lut[di];
                    const bool valid = own ? (dist >= 0) : lanesel;
                    x[r] = valid ? v : -INFINITY;
                }
            }
            float mx = x[0];
#pragma unroll
            for (int r = 1; r < 16; ++r) mx = fmaxf(mx, x[r]);
            mx = fmaxf(mx, __shfl_xor(mx, 32));
            const float m_new = fmaxf(m_run, mx);
            const float alpha = __builtin_amdgcn_exp2f(m_run - m_new);
            float p[16]; float ls = 0.f;
#pragma unroll
            for (int r = 0; r < 16; ++r) { p[r] = __builtin_amdgcn_exp2f(x[r] - m_new); ls += p[r]; }
            l_run = l_run * alpha + ls; m_run = m_new;
#pragma unroll
            for (int r = 0; r < 16; ++r) { o0[r] *= alpha; o1[r] *= alpha; }
            const bf16x8 pb0 = pack8f(p), pb1 = pack8f(p + 8);
            o0 = MFMA32(cur.v[0][0], pb0, o0); o0 = MFMA32(cur.v[0][1], pb1, o0);
            o1 = MFMA32(cur.v[1][0], pb0, o1); o1 = MFMA32(cur.v[1][1], pb1, o1);
        }
        if (!has_next) break;
        if (in_own && tokn < tok) in_own = false;
        if (in_own && !(tok < c * 256 + sub * 32)) in_own = false;
        cur = nxt; tok = tokn;
    }
    const float l = l_run + __shfl_xor(l_run, 32);
    store_o(O + qrow * 1024 + 512 + h * 64 + 8 * hi, o0, o1, 1.f / l);
}

__device__ __forceinline__ void sb_wave(int b, int h, int qblk, int sub, const bf16_t* QK, const bf16_t* VT, bf16_t* O, int lane) {
    const int ql = lane & 31, hi = lane >> 5;
    const int tq = qblk * 256 + sub * 32 + ql;
    const size_t qrow = (size_t)b * SEQ + tq;
    bf16x8 qf[4];
    { const bf16_t* qp = QK + qrow * 2048 + h * 64 + 8 * hi;
#pragma unroll
      for (int s = 0; s < 4; ++s) qf[s] = *(const bf16x8*)(qp + 16 * s); }
    const bf16_t* kbase = QK + (size_t)b * SEQ * 2048 + 512 + h * 64 + 8 * hi + (size_t)swap23(ql) * 2048;
    const bf16_t* vbase = VT + ((size_t)(b * 8 + h) * 64 + swap23(ql)) * 2048 + 8 * hi;
    f32x16 o0, o1;
#pragma unroll
    for (int r = 0; r < 16; ++r) { o0[r] = 0.f; o1[r] = 0.f; }
    float carry = 0.f;
    const int tdiag = qblk * 256 + sub * 32;
    int tok = tdiag;
    Frag cur, nxt;
    load_tile(cur, kbase + (size_t)tok * 2048, vbase + tok);
    for (;;) {
        const bool has_next = tok > 0;
        if (has_next) load_tile(nxt, kbase + (size_t)(tok - 32) * 2048, vbase + (tok - 32));
        {
            f32x16 S;
#pragma unroll
            for (int r = 0; r < 16; ++r) S[r] = 0.f;
#pragma unroll
            for (int s = 0; s < 4; ++s) S = MFMA32(cur.k[s], qf[s], S);
            asm volatile("" :: "v"(cur.k[0]), "v"(cur.k[1]), "v"(cur.k[2]), "v"(cur.k[3]));
            const bool diag = (tok == tdiag);
            float lf[16], zl[16];
            float G0 = 0.f, G1 = 0.f;
#pragma unroll
            for (int r = 0; r < 16; ++r) {
                const int kl = (r & 7) + 8 * hi + 16 * (r >> 3);
                const float z = S[r] * 0.125f;
                const float e = __expf(-fabsf(z));
                float f = -(fmaxf(z, 0.f) + __logf(1.f + e));
                const bool causal = !diag || (kl < ql);
                zl[r] = causal ? (z + f) : -INFINITY;
                f = causal ? f : 0.f; lf[r] = f;
                if (r < 8) G0 += f; else G1 += f;
            }
            const float P0 = __shfl_xor(G0, 32), P1 = __shfl_xor(G1, 32);
            const float a0 = hi ? (P1 + G1) : ((P0 + G1) + P1), a1 = hi ? 0.f : P1;
            float w[16];
            float run = carry + a1;
#pragma unroll
            for (int e = 7; e >= 0; --e) { w[8 + e] = __expf(zl[8 + e] + run); run += lf[8 + e]; }
            run = carry + a0;
#pragma unroll
            for (int e = 7; e >= 0; --e) { w[e] = __expf(zl[e] + run); run += lf[e]; }
            carry += (G0 + G1) + (P0 + P1);
            const bf16x8 pb0 = pack8f(w), pb1 = pack8f(w + 8);
            o0 = MFMA32(cur.v[0][0], pb0, o0); o0 = MFMA32(cur.v[0][1], pb1, o0);
            o1 = MFMA32(cur.v[1][0], pb0, o1); o1 = MFMA32(cur.v[1][1], pb1, o1);
        }
        if (!has_next) break;
        if (__ballot(carry > -104.f) == 0ull) break;
        cur = nxt; tok -= 32;
    }
    store_o(O + qrow * 1024 + h * 64 + 8 * hi, o0, o1, 1.f);
}
}

namespace att2 {
using att::bf16x8; using att::f32x16; using att::Frag; using att::swap23; using att::pack8f; using att::bf2f; using att::store_o;
constexpr int BUF_BYTES = 65536;
__device__ __forceinline__ float xor32f(float v, int hi) { const unsigned u = __float_as_uint(v); const auto r = __builtin_amdgcn_permlane32_swap(u, u, false, false); return __uint_as_float(hi ? r[0] : r[1]); }
struct Stage { u32x4 k[4]; u32x4 v[4]; };
__device__ __forceinline__ void blk_load(Stage& st, const bf16_t* kg, const bf16_t* vg, int t) {
#pragma unroll
    for (int i = 0; i < 4; ++i) { const int p = t + 512 * i; st.k[i] = *(const u32x4*)(kg + (size_t)(p >> 3) * 2048 + (p & 7) * 8); }
#pragma unroll
    for (int i = 0; i < 4; ++i) { const int p = t + 512 * i; st.v[i] = *(const u32x4*)(vg + (size_t)(p >> 5) * 2048 + (p & 31) * 8); }
}
__device__ __forceinline__ void blk_store(const Stage& st, LAS unsigned char* buf, int t) {
#pragma unroll
    for (int i = 0; i < 4; ++i) { const int p = t + 512 * i, r = p >> 3, c = p & 7; *(LAS u32x4*)(buf + r * 128 + ((c ^ ((r >> 1) & 7)) << 4)) = st.k[i]; }
#pragma unroll
    for (int i = 0; i < 4; ++i) { const int p = t + 512 * i, d = p >> 5, c = p & 31; *(LAS u32x4*)(buf + 32768 + d * 512 + ((c ^ (d & 15)) << 4)) = st.v[i]; }
}
__device__ __forceinline__ void tile_frags(Frag& f, const LAS unsigned char* buf, int kt, int sq, int hi) {
    const LAS unsigned char* kp = buf + (kt * 32 + sq) * 128; const int kx = (sq >> 1) & 7;
#pragma unroll
    for (int s = 0; s < 4; ++s) f.k[s] = *(const LAS bf16x8*)(kp + (((2 * s + hi) ^ kx) << 4));
    const int vx = sq & 15;
#pragma unroll
    for (int dt = 0; dt < 2; ++dt)
#pragma unroll
        for (int g = 0; g < 2; ++g) f.v[dt][g] = *(const LAS bf16x8*)(buf + 32768 + (32 * dt + sq) * 512 + (((4 * kt + 2 * g + hi) ^ vx) << 4));
}
__device__ __forceinline__ void wg_barrier() { __syncthreads(); }
__device__ __forceinline__ void lds_barrier() { asm volatile("s_waitcnt lgkmcnt(0)" ::: "memory"); __builtin_amdgcn_s_barrier(); asm volatile("" ::: "memory"); }

struct MobaSt { f32x16 o0, o1; float m_run, l_run; };
__device__ __forceinline__ void moba_tile(MobaSt& st, const Frag& cur, const bf16x8 (&qf)[4], int tok, int c, int tq, int hi, unsigned sel, const LAS float* lut, float bfar) {
    const float c2 = 0.125f * LOG2E;
    const int jb = tok >> 8; const bool own = (jb == c);
    f32x16 S;
#pragma unroll
    for (int r = 0; r < 16; ++r) S[r] = 0.f;
    __builtin_amdgcn_s_setprio(1);
#pragma unroll
    for (int s = 0; s < 4; ++s) S = MFMA32(cur.k[s], qf[s], S);
    __builtin_amdgcn_s_setprio(0);
    asm volatile("" :: "v"(cur.k[0]), "v"(cur.k[1]), "v"(cur.k[2]), "v"(cur.k[3]));
    float p[16]; float ls = 0.f; float m_new;
    if ((tq & ~31) - tok >= 144) {
        const bool lanesel = own || (((sel >> jb) & 1u) != 0u);
        float ms = S[0];
#pragma unroll
        for (int r = 1; r < 16; ++r) ms = fmaxf(ms, S[r]);
        float mx = lanesel ? (ms * c2 + bfar) : -INFINITY;
        mx = fmaxf(mx, xor32f(mx, hi));
        m_new = fmaxf(st.m_run, mx);
        const float nb = lanesel ? (bfar - m_new) : -INFINITY;
#pragma unroll
        for (int r = 0; r < 16; ++r) { p[r] = __builtin_amdgcn_exp2f(S[r] * c2 + nb); ls += p[r]; }
    } else {
        const int dist0 = tq - tok - 8 * hi;
        const bool lanesel = own || ((sel >> jb) & 1u);
        float x[16];
#pragma unroll
        for (int r = 0; r < 16; ++r) {
            const int dist = dist0 - ((r & 7) + 16 * (r >> 3));
            const int di = dist < 0 ? 0 : (dist > 127 ? 127 : dist);
            const float v = S[r] * c2 + lut[di];
            const bool valid = own ? (dist >= 0) : lanesel;
            x[r] = valid ? v : -INFINITY;
        }
        float mx = x[0];
#pragma unroll
        for (int r = 1; r < 16; ++r) mx = fmaxf(mx, x[r]);
        mx = fmaxf(mx, xor32f(mx, hi));
        m_new = fmaxf(st.m_run, mx);
#pragma unroll
        for (int r = 0; r < 16; ++r) { p[r] = __builtin_amdgcn_exp2f(x[r] - m_new); ls += p[r]; }
    }
    const float alpha = __builtin_amdgcn_exp2f(st.m_run - m_new);
    st.l_run = st.l_run * alpha + ls;
    if (__ballot(m_new > st.m_run) != 0ull) {
#pragma unroll
        for (int r = 0; r < 16; ++r) { st.o0[r] *= alpha; st.o1[r] *= alpha; }
    }
    st.m_run = m_new;
    const bf16x8 pb0 = pack8f(p), pb1 = pack8f(p + 8);
    __builtin_amdgcn_s_setprio(1);
    st.o0 = MFMA32(cur.v[0][0], pb0, st.o0); st.o1 = MFMA32(cur.v[1][0], pb0, st.o1);
    st.o0 = MFMA32(cur.v[0][1], pb1, st.o0); st.o1 = MFMA32(cur.v[1][1], pb1, st.o1);
    __builtin_amdgcn_s_setprio(0);
}

__device__ __forceinline__ void moba_unit(int b, int h, int c, int sub, const bf16_t* QK, const bf16_t* VT, const float* kpart, bf16_t* O,
                                          const LAS float* lut, LAS float* kb, LAS unsigned* ctl, LAS unsigned char* bufs, int wave, int lane, int t,
                                          Stage& stg, const bf16_t* nkg, const bf16_t* nvg) {
    const int ql = lane & 31, hi = lane >> 5, sq = swap23(ql);
    const int tq = c * 256 + sub * 32 + ql;
    const size_t qrow = (size_t)b * SEQ + tq;
    const bf16_t* kg0 = QK + (size_t)b * SEQ * 2048 + 1536 + h * 64;
    const bf16_t* vg0 = VT + ((size_t)((32 + b) * 8 + h) * 64) * 2048;
    { float ka[7], kc[7];
#pragma unroll
      for (int j = 0; j < 7; ++j) { const float* kp = kpart + (size_t)((b * 8 + (j < c ? j : 0)) * 2) * 512 + h * 64 + lane; ka[j] = kp[0]; kc[j] = kp[512]; }
#pragma unroll
      for (int j = 0; j < 7; ++j) if (j < c) kb[j * 64 + lane] = (ka[j] + kc[j]) * (1.f / 256.f); }
    asm volatile("s_waitcnt lgkmcnt(0)" ::: "memory");
    bf16x8 qf[4];
    { const bf16_t* qp = QK + qrow * 2048 + 1024 + h * 64 + 8 * hi;
#pragma unroll
      for (int s = 0; s < 4; ++s) qf[s] = *(const bf16x8*)(qp + 16 * s); }
    unsigned sel;
    if (c <= 3) sel = (1u << c) - 1u;
    else {
        float g[7];
#pragma unroll
        for (int j = 0; j < 7; ++j) {
            float a = -INFINITY;
            if (j < c) {
                a = 0.f;
#pragma unroll
                for (int s = 0; s < 4; ++s)
#pragma unroll
                    for (int e = 0; e < 8; ++e) a += bf2f(qf[s][e]) * kb[j * 64 + 16 * s + 8 * hi + e];
                a += __shfl_xor(a, 32);
            }
            g[j] = a;
        }
        sel = 0u;
#pragma unroll
        for (int k = 0; k < 3; ++k) {
            float best = -INFINITY; int bi = 0;
#pragma unroll
            for (int j = 0; j < 7; ++j) { const bool tt = !((sel >> j) & 1u) && g[j] > best; best = tt ? g[j] : best; bi = tt ? j : bi; }
            sel |= 1u << bi;
        }
    }
    unsigned remw = 0u;
    for (int j = 0; j < c; ++j) if (__ballot((sel >> j) & 1u) != 0ull) remw |= 1u << j;
    remw = __builtin_amdgcn_readfirstlane(remw);
    if (lane == 0) ctl[wave] = remw;
    blk_store(stg, bufs, t);
    __builtin_amdgcn_s_waitcnt(0x0F70);
    wg_barrier();
    unsigned rem = 0u;
#pragma unroll
    for (int w = 0; w < 8; ++w) rem |= ctl[w];
    rem = __builtin_amdgcn_readfirstlane(rem);

    MobaSt st;
#pragma unroll
    for (int r = 0; r < 16; ++r) { st.o0[r] = 0.f; st.o1[r] = 0.f; }
    st.m_run = -INFINITY; st.l_run = 0.f;
    const float bfar = lut[127];
    int jb = c, i = 0;
    for (;;) {
        int jn = -1; if (rem) { jn = __builtin_ctz(rem); rem &= rem - 1u; }
        if (jn >= 0) blk_load(stg, kg0 + (size_t)jn * 256 * 2048, vg0 + jn * 256, t);
        const LAS unsigned char* buf = bufs + (i & 1) * BUF_BYTES;
        if (jb == c || ((remw >> jb) & 1u)) {
            const int nkt = (jb == c) ? sub + 1 : 8;
            for (int kt = 0; kt < nkt; ++kt) { Frag f; tile_frags(f, buf, kt, sq, hi); moba_tile(st, f, qf, jb * 256 + kt * 32, c, tq, hi, sel, lut, bfar); }
        }
        if (jn < 0) break;
        blk_store(stg, bufs + ((i + 1) & 1) * BUF_BYTES, t);
        wg_barrier();
        jb = jn; ++i;
    }
    if (nkg) blk_load(stg, nkg, nvg, t);
    const float l = st.l_run + __shfl_xor(st.l_run, 32);
    store_o(O + qrow * 1024 + 512 + h * 64 + 8 * hi, st.o0, st.o1, 1.f / l);
    lds_barrier();
}

struct SbSt { f32x16 o0, o1; float carry; };
template <bool DIAG> __device__ __forceinline__ void sb_tile(SbSt& st, const Frag& cur, const bf16x8 (&qf)[4], int ql, int hi) {
    f32x16 S;
#pragma unroll
    for (int r = 0; r < 16; ++r) S[r] = 0.f;
    __builtin_amdgcn_s_setprio(1);
#pragma unroll
    for (int s = 0; s < 4; ++s) S = MFMA32(cur.k[s], qf[s], S);
    __builtin_amdgcn_s_setprio(0);
    asm volatile("" :: "v"(cur.k[0]), "v"(cur.k[1]), "v"(cur.k[2]), "v"(cur.k[3]));
    float bt[16], om[16];
    float G0 = 1.f, G1 = 1.f;
#pragma unroll
    for (int r = 0; r < 16; ++r) {
        const float e = __builtin_amdgcn_exp2f(-fabsf(S[r]) * (0.125f * LOG2E));
        const float rc = __builtin_amdgcn_rcpf(1.f + e), er = e * rc;
        float beta = S[r] > 0.f ? rc : er, omb = S[r] > 0.f ? er : rc;
        if (DIAG) { const int kl = (r & 7) + 8 * hi + 16 * (r >> 3); const bool causal = kl < ql; beta = causal ? beta : 0.f; omb = causal ? omb : 1.f; }
        bt[r] = beta; om[r] = omb;
        if (r < 8) G0 *= omb; else G1 *= omb;
    }
    const float P0 = xor32f(G0, hi), P1 = xor32f(G1, hi);
    const float a0 = hi ? (P1 * G1) : ((P0 * G1) * P1), a1 = hi ? 1.f : P1;
    float w[16];
    float run = st.carry * a1;
#pragma unroll
    for (int e = 7; e >= 0; --e) { w[8 + e] = bt[8 + e] * run; run *= om[8 + e]; }
    run = st.carry * a0;
#pragma unroll
    for (int e = 7; e >= 0; --e) { w[e] = bt[e] * run; run *= om[e]; }
    st.carry *= (G0 * G1) * (P0 * P1);
    const bf16x8 pb0 = pack8f(w), pb1 = pack8f(w + 8);
    __builtin_amdgcn_s_setprio(1);
    st.o0 = MFMA32(cur.v[0][0], pb0, st.o0); st.o1 = MFMA32(cur.v[1][0], pb0, st.o1);
    st.o0 = MFMA32(cur.v[0][1], pb1, st.o0); st.o1 = MFMA32(cur.v[1][1], pb1, st.o1);
    __builtin_amdgcn_s_setprio(0);
}
__device__ __forceinline__ bool sb_dead(const SbSt& st) { return __ballot(st.carry >= 1.17549435e-38f) == 0ull; }

__device__ __forceinline__ void sb_unit(int b, int h, int qblk, int sub, const bf16_t* QK, const bf16_t* VT, bf16_t* O,
                                        LAS unsigned* ctl, LAS unsigned char* bufs, int wave, int lane, int t, Stage& stg, const bf16_t* nkg, const bf16_t* nvg) {
    const int ql = lane & 31, hi = lane >> 5, sq = swap23(ql);
    const int tq = qblk * 256 + sub * 32 + ql;
    const size_t qrow = (size_t)b * SEQ + tq;
    const bf16_t* kg0 = QK + (size_t)b * SEQ * 2048 + 512 + h * 64;
    const bf16_t* vg0 = VT + ((size_t)(b * 8 + h) * 64) * 2048;
    Stage stg2;
    if (qblk > 0) blk_load(stg2, kg0 + (size_t)(qblk - 1) * 256 * 2048, vg0 + (qblk - 1) * 256, t);
    bf16x8 qf[4];
    { const bf16_t* qp = QK + qrow * 2048 + h * 64 + 8 * hi;
#pragma unroll
      for (int s = 0; s < 4; ++s) qf[s] = *(const bf16x8*)(qp + 16 * s); }
    if (t < 8) ctl[8 + t] = 0u;
    blk_store(stg, bufs, t);
    if (qblk > 0) blk_store(stg2, bufs + BUF_BYTES, t);
    __builtin_amdgcn_s_waitcnt(0x0F70);
    wg_barrier();
    if (nkg) blk_load(stg, nkg, nvg, t);
    SbSt st;
#pragma unroll
    for (int r = 0; r < 16; ++r) { st.o0[r] = 0.f; st.o1[r] = 0.f; }
    st.carry = 1.f;
    bool done = false;
    { Frag f; tile_frags(f, bufs, sub, sq, hi); sb_tile<true>(st, f, qf, ql, hi); done = sb_dead(st); }
    for (int kt = sub - 1; kt >= 0 && !done; --kt) { Frag f; tile_frags(f, bufs, kt, sq, hi); sb_tile<false>(st, f, qf, ql, hi); done = sb_dead(st); }
    if (qblk > 0)
        for (int kt = 7; kt >= 0 && !done; --kt) { Frag f; tile_frags(f, bufs + BUF_BYTES, kt, sq, hi); sb_tile<false>(st, f, qf, ql, hi); done = sb_dead(st); }
    int jb = qblk - 2, i = 0;
    for (;;) {
        if (!done && jb >= 0 && lane == 0) ctl[8 + i] = 1u;
        wg_barrier();
        if (jb < 0 || ctl[8 + i] == 0u) break;
        blk_load(stg2, kg0 + (size_t)jb * 256 * 2048, vg0 + jb * 256, t);
        blk_store(stg2, bufs + (i & 1) * BUF_BYTES, t);
        wg_barrier();
        for (int kt = 7; kt >= 0 && !done; --kt) { Frag f; tile_frags(f, bufs + (i & 1) * BUF_BYTES, kt, sq, hi); sb_tile<false>(st, f, qf, ql, hi); done = sb_dead(st); }
        --jb; ++i;
    }
    store_o(O + qrow * 1024 + h * 64 + 8 * hi, st.o0, st.o1, 1.f);
    lds_barrier();
}
}

__device__ __forceinline__ float wave_sum(float v) {
#pragma unroll
    for (int o = 1; o < 64; o <<= 1) v += __shfl_xor(v, o);
    return v;
}
__device__ __forceinline__ void p0_transpose_item(const float* W, int K, int N, const float* gk, bf16_t* WT, int k0, int n0, int dst_row0, LAS float* scr, int lane) {
    {
        f32x4 w4[8]; const int c4 = (lane & 7) * 4, kr = lane >> 3;
#pragma unroll
        for (int i = 0; i < 8; ++i) w4[i] = *(const f32x4*)(W + (size_t)(k0 + 8 * i + kr) * N + n0 + c4);
#pragma unroll
        for (int i = 0; i < 8; ++i) { const int kk = 8 * i + kr; f32x4 w = w4[i]; if (gk) w = w * gk[k0 + kk];
            LAS float* d = scr + kk * 33 + c4; d[0] = w[0]; d[1] = w[1]; d[2] = w[2]; d[3] = w[3]; }
    }
    asm volatile("s_waitcnt lgkmcnt(0)" ::: "memory");
    const int c = lane & 7;
#pragma unroll
    for (int j = 0; j < 4; ++j) { const int n = (lane >> 3) + 8 * j; const LAS float* s = scr + (8 * c) * 33 + n;
        u32x4 o; o.x = cvt_pk_bf16(s[0 * 33], s[1 * 33]); o.y = cvt_pk_bf16(s[2 * 33], s[3 * 33]); o.z = cvt_pk_bf16(s[4 * 33], s[5 * 33]); o.w = cvt_pk_bf16(s[6 * 33], s[7 * 33]);
        *(u32x4*)(WT + (size_t)(dst_row0 + n) * K + k0 + 8 * c) = o; }
    asm volatile("s_waitcnt lgkmcnt(0)" ::: "memory");
}

struct Args { const float* in[18]; float* out; unsigned char* ws; };

#define XB_TMO      128
#define XB_XCNT(j)  (256  + 64 * (j))
#define XB_XSUB(j)  (1280 + 64 * (j))
#define XB_XGEN(j)  (2304 + 64 * (j))
#define XB_TOP      3328
#define XB_TOPGEN   3392
#define XCD_BAR_WORDS 3456
#define XB_SPIN_CAP (1u << 18)

__device__ __forceinline__ unsigned xb_ld(unsigned* p)              { return __hip_atomic_load(p, __ATOMIC_RELAXED, __HIP_MEMORY_SCOPE_AGENT); }
__device__ __forceinline__ unsigned xb_add(unsigned* p, unsigned v) { return __hip_atomic_fetch_add(p, v, __ATOMIC_RELAXED, __HIP_MEMORY_SCOPE_AGENT); }
__device__ __forceinline__ unsigned xb_xcc_id() { return (unsigned)__builtin_amdgcn_s_getreg((3 << 11) | 20) & 0xFu; }
#define XB_SPIN(cond, bar) do { unsigned _sp = 0; while (cond) { __builtin_amdgcn_s_sleep(1); \
    if ((++_sp & 255u) == 0u) { if (xb_ld(&(bar)[XB_TMO])) break; if (_sp > XB_SPIN_CAP) { atomicAdd(&(bar)[XB_TMO], 1u); break; } } } } while (0)

struct XcdBarrier {
    unsigned* bar; unsigned x;
    volatile LAS unsigned* st;
};

__device__ __forceinline__ XcdBarrier xcd_barrier_post(unsigned* bar, volatile LAS unsigned* st) {
    XcdBarrier b; b.bar = bar; b.x = xb_xcc_id(); b.st = st;
    if (threadIdx.x == 0) (void)xb_add(&bar[XB_XCNT(b.x)], 1u);
    return b;
}
__device__ __forceinline__ void xcd_barrier_complete(unsigned* bar, unsigned x, unsigned& nloc, unsigned& nx) {
    const unsigned G = gridDim.x * gridDim.y * gridDim.z;
    unsigned sum, cnt, mine, sp = 0u;
    for (;;) {
        sum = 0u; cnt = 0u; mine = 0u;
#pragma unroll
        for (unsigned j = 0; j < 16; ++j) { const unsigned c = xb_ld(&bar[XB_XCNT(j)]); sum += c; cnt += (c > 0u) ? 1u : 0u; mine = (j == x) ? c : mine; }
        if (sum == G) break;
        __builtin_amdgcn_s_sleep(1);
        if ((++sp & 255u) == 0u) { if (xb_ld(&bar[XB_TMO])) break; if (sp > XB_SPIN_CAP) { atomicAdd(&bar[XB_TMO], 1u); break; } }
    }
    nloc = mine > 0u ? mine : 1u; nx = cnt > 0u ? cnt : 1u;
}

__device__ __forceinline__ void xcd_barrier(const XcdBarrier& b) {
    asm volatile("s_waitcnt vmcnt(0)" ::: "memory");
    __syncthreads();
    if (threadIdx.x == 0) {
        unsigned* bar = b.bar;
        __builtin_amdgcn_s_waitcnt(0);
        unsigned nloc = b.st[0], nx = b.st[1];
        if (nloc == 0u) { xcd_barrier_complete(bar, b.x, nloc, nx); b.st[0] = nloc; b.st[1] = nx; }
        const unsigned old = xb_add(&bar[XB_XSUB(b.x)], 1u);
        const unsigned gen = old / nloc;
        if (old + 1u == (gen + 1u) * nloc) {
            __builtin_amdgcn_fence(__ATOMIC_RELEASE, "agent");
            asm volatile("s_waitcnt vmcnt(0)" ::: "memory");
            const unsigned og = xb_add(&bar[XB_TOP], 1u);
            const unsigned tg = og / nx;
            if (og + 1u == (tg + 1u) * nx) xb_add(&bar[XB_TOPGEN], 1u);
            else XB_SPIN(xb_ld(&bar[XB_TOPGEN]) == tg, bar);
            __builtin_amdgcn_fence(__ATOMIC_ACQUIRE, "agent");
            xb_add(&bar[XB_XGEN(b.x)], 1u);
            asm volatile("s_waitcnt vmcnt(0)" ::: "memory");
        } else {
            XB_SPIN(xb_ld(&bar[XB_XGEN(b.x)]) == gen, bar);
            __builtin_amdgcn_fence(__ATOMIC_ACQUIRE, "agent");
            asm volatile("s_waitcnt vmcnt(0)" ::: "memory");
        }
    }
    __syncthreads();
}

__device__ __forceinline__ void chain_fence() { __builtin_amdgcn_fence(__ATOMIC_ACQUIRE, "workgroup"); }
__device__ __forceinline__ void compute_rs(const float* ssq, int pm, LAS float* rs, int tid_) {
    int tid = tid_; asm volatile("" : "+v"(tid));
    if (tid < 256) { const f32x4* p = (const f32x4*)(ssq + (size_t)(pm * 256 + tid) * 16); const f32x4 a = p[0], b = p[1], c = p[2], d = p[3];
        const float s = (((a[0] + a[1]) + (a[2] + a[3])) + ((b[0] + b[1]) + (b[2] + b[3]))) + (((c[0] + c[1]) + (c[2] + c[3])) + ((d[0] + d[1]) + (d[2] + d[3])));
        rs[tid] = rsqrtf(s * (1.f / DM) + EPS); }
    __syncthreads();
}

__device__ __forceinline__ int lane_id_() { int l; asm volatile("v_mbcnt_lo_u32_b32 %0, -1, 0\n\tv_mbcnt_hi_u32_b32 %0, -1, %0" : "=v"(l)); return l; }
template <int PLO, int PHI>
__global__ void __launch_bounds__(512, 2) fwd_megakernel(Args args) {
    extern __shared__ __attribute__((aligned(16))) unsigned char lds_raw[];
    LAS unsigned char* lds = (LAS unsigned char*)lds_raw;
    cg::grid_group grid = cg::this_grid();
    const int wave = __builtin_amdgcn_readfirstlane((int)threadIdx.x >> 6);
#define lane (lane_id_())
#define tid (wave * 64 + lane)
    const int G = gridDim.x, bx = blockIdx.x;
    unsigned char* ws = args.ws;
    const float* x = args.in[0]; float* out = args.out;
    float* rstd0 = (float*)(ws + WS_RSTD0); float* kpart = (float*)(ws + WS_KPART);
    bf16_t* W1t = (bf16_t*)(ws + WS_W1T); bf16_t* Wvt = (bf16_t*)(ws + WS_WVT); bf16_t* W3t = (bf16_t*)(ws + WS_W3T); bf16_t* Wot = (bf16_t*)(ws + WS_WOT); bf16_t* Wgut = (bf16_t*)(ws + WS_WGUT);
    bf16_t* Wdt = (bf16_t*)(ws + WS_WDT); bf16_t* Wpgt = (bf16_t*)(ws + WS_WPGT); bf16_t* Wppt = (bf16_t*)(ws + WS_WPPT);
    float* ssq1 = (float*)(ws + WS_SSQ1); float* ssq2 = (float*)(ws + WS_SSQ2); float* ssq3 = (float*)(ws + WS_SSQ3);
    bf16_t* PB = (bf16_t*)(ws + WS_PB); bf16_t* XB = (bf16_t*)(ws + WS_XB); bf16_t* QK = (bf16_t*)(ws + WS_QK); bf16_t* VT = (bf16_t*)(ws + WS_VT);
    bf16_t* HB = (bf16_t*)(ws + WS_H); bf16_t* Gt = (bf16_t*)(ws + WS_GT); bf16_t* PP = (bf16_t*)out; bf16_t* A2 = (bf16_t*)(ws + WS_A2);
    bf16_t* MIX = XB; bf16_t* XB2 = XB; bf16_t* XB1 = A2; bf16_t* XB3 = A2;
    LAS float* rs = (LAS float*)(lds + RS_OFF);
    volatile LAS unsigned* xb_st = (volatile LAS unsigned*)(lds + 151680);
    if (threadIdx.x < 2) xb_st[threadIdx.x] = 0u;
    __syncthreads();
    XcdBarrier xbar = xcd_barrier_post((unsigned*)(ws + WS_RSTD0 + 512 * 1024), xb_st);
    if (args.ws == nullptr) grid.sync();
#if PROBE_T
    const unsigned long long t_start = __builtin_amdgcn_s_memrealtime(); float t_probe = 0.f;
#define STAMP(k) do { if (PROBE_T == (k)) t_probe = (float)(__builtin_amdgcn_s_memrealtime() - t_start) * 0.01f; } while (0)
#else
#define STAMP(k) do {} while (0)
#endif

#define PH_IN(k) (PLO <= (k) && (k) < PHI)
    if constexpr (PH_IN(0)) {
        LAS float* scr = (LAS float*)(lds + wave * 16384);
        const int gw = bx * 8 + wave, NGW = G * 8;
        constexpr int I1 = 16 * 96, I2 = 16 * 64, I3 = 8 * 32, I5 = 16 * 32, I6 = 16 * 88, I8 = 44 * 32, I10 = 4 * 32;
        constexpr int NITEMS = I1 + I2 + 2 * I3 + I5 + 2 * I6 + I8 + I5 + I10;
        for (int it = gw; it < NITEMS; it += NGW) {
            int r = it;
            if (r < I1) { const int kb = r / 96, nb = r % 96, n0 = 32 * nb, grp = n0 >> 9, o = n0 & 511;
                bf16_t* dW = (grp == 2 || grp == 5) ? Wvt : W1t; const int dr = (grp == 2 ? 0 : grp == 5 ? 512 : grp == 0 ? 0 : grp == 1 ? 512 : grp == 3 ? 1024 : 1536) + o;
                p0_transpose_item(args.in[3], 1024, 3072, args.in[2], dW, 64 * kb, n0, dr, scr, lane); continue; } r -= I1;
            if (r < I2) { const int kb = r / 64, nb = r % 64; p0_transpose_item(args.in[4], 1024, 2048, args.in[2], W1t, 64 * kb, 32 * nb, 2048 + 32 * nb, scr, lane); continue; } r -= I2;
            if (r < I3) { const int kb = r / 32, nb = r % 32; p0_transpose_item(args.in[6], 512, 1024, nullptr, W3t, 64 * kb, 32 * nb, 32 * nb, scr, lane); continue; } r -= I3;
            if (r < I3) { const int kb = r / 32, nb = r % 32; p0_transpose_item(args.in[7], 512, 1024, nullptr, W3t, 64 * kb, 32 * nb, 1024 + 32 * nb, scr, lane); continue; } r -= I3;
            if (r < I5) { const int kb = r / 32, nb = r % 32; p0_transpose_item(args.in[8], 1024, 1024, nullptr, Wot, 64 * kb, 32 * nb, 32 * nb, scr, lane); continue; } r -= I5;
            if (r < I6) { const int kb = r / 88, nb = r % 88, n0 = 32 * nb; p0_transpose_item(args.in[11], 1024, FFH, args.in[10], Wgut, 64 * kb, n0, 256 * (n0 >> 7) + (n0 & 127), scr, lane); continue; } r -= I6;
            if (r < I6) { const int kb = r / 88, nb = r % 88, n0 = 32 * nb; p0_transpose_item(args.in[12], 1024, FFH, args.in[10], Wgut, 64 * kb, n0, 256 * (n0 >> 7) + 128 + (n0 & 127), scr, lane); continue; } r -= I6;
            if (r < I8) { const int kb = r / 32, nb = r % 32; p0_transpose_item(args.in[13], FFH, 1024, nullptr, Wdt, 64 * kb, 32 * nb, 32 * nb, scr, lane); continue; } r -= I8;
            if (r < I5) { const int kb = r / 32, nb = r % 32; p0_transpose_item(args.in[15], 1024, 1024, args.in[14], Wpgt, 64 * kb, 32 * nb, 32 * nb, scr, lane); continue; } r -= I5;
            { const int kb = r / 32, nb = r % 32; p0_transpose_item(args.in[16], PLE, 1024, nullptr, Wppt, 64 * kb, 32 * nb, 32 * nb, scr, lane); }
        }
        for (int m0 = gw * 32; m0 < MTOK; m0 += NGW * 32)
        for (int m = m0; m < m0 + 32; ++m) {
            const f32x4* xr = (const f32x4*)(x + (size_t)m * DM) + lane; f32x4 v[4]; float s = 0.f;
#pragma unroll
            for (int j = 0; j < 4; ++j) { v[j] = xr[64 * j]; s += (v[j][0] * v[j][0] + v[j][1] * v[j][1]) + (v[j][2] * v[j][2] + v[j][3] * v[j][3]); }
            s = wave_sum(s);
            if (lane == 0) rstd0[m] = rsqrtf(s * (1.f / DM) + EPS);
            u32x2* o8 = (u32x2*)(XB + (size_t)m * DM) + lane;
#pragma unroll
            for (int j = 0; j < 4; ++j) { u32x2 w; w.x = cvt_pk_bf16(v[j][0], v[j][1]); w.y = cvt_pk_bf16(v[j][2], v[j][3]); o8[64 * j] = w; }
        }
        const float* p = args.in[1];
        for (size_t i = (size_t)bx * 512 + tid; i < (size_t)MTOK * PLE / 8; i += (size_t)G * 512) {
            const f32x4 a = *(const f32x4*)(p + i * 8), b = *(const f32x4*)(p + i * 8 + 4);
            *(u32x4*)(PB + i * 8) = pack8(a, b);
        }
    }
    if constexpr (PH_IN(0) && PH_IN(1)) {
    xcd_barrier(xbar);
    }
    STAMP(1);

    if constexpr (PH_IN(1)) if (bx < NP) for (int rep_ = 0; rep_ < REP_P1; ++rep_) { const int pm = bx;
        { pg8::Gemm g{XB, W1t, 1024, 1024}; XcdOrder S; S.init(NP, 16, G, bx, 4);
          Epi1 E{rstd0, args.in[5], QK, Gt, kpart};
          pg8::gemm_phase<Epi1, XcdOrder, true, true>(lds, g, S, E, wave); }
        { pg8::Gemm g{Wvt, XB, 1024, 1024}; XcdOrder S; S.init(4, NP, G, bx);
          EpiVT E{rstd0, VT};
          pg8::gemm_phase<EpiVT, XcdOrder, true, true>(lds, g, S, E, wave); }
        { pg8::Gemm g{PB, Wppt, PLE, PLE}; XcdOrder S; S.init(NP, 4, G, bx);
          EpiPP E{PP};
          pg8::gemm_phase<EpiPP, XcdOrder, true, true>(lds, g, S, E, wave); }
    }
    if constexpr (PH_IN(1) && PH_IN(2)) {
    xcd_barrier(xbar);
    }
    STAMP(2);

    if constexpr (PH_IN(2)) {
        LAS float* lut = (LAS float*)(lds + 131072);
        LAS float* kb = (LAS float*)(lds + 135168 + wave * 2048);
        LAS unsigned* ctl = (LAS unsigned*)(lds + 151552);
        const float* rel_bias = args.in[9];
        for (int i = tid; i < 1024; i += 512) { const int hh = i >> 7, d = i & 127;
            int bk = d; if (d >= 16) { bk = 16 + (int)(logf((float)d / 16.f) / logf(8.f) * 16.f); bk = bk > 31 ? 31 : bk; }
            lut[i] = rel_bias[bk * 8 + hh] * LOG2E; }
        __syncthreads();
#define UNIT_KG(u) (QK + (size_t)(((u) & 255) >> 3) * SEQ * 2048 + ((u) < 2048 ? 1536 : 512) + (((u) & 255) & 7) * 64 + (size_t)(7 - (((u) & 2047) >> 8)) * 256 * 2048)
#define UNIT_VG(u) (VT + ((size_t)((((u) < 2048 ? 32 : 0) + (((u) & 255) >> 3)) * 8 + (((u) & 255) & 7)) * 64) * 2048 + (7 - (((u) & 2047) >> 8)) * 256)
        att2::Stage stg;
        if (bx < 4096) att2::blk_load(stg, UNIT_KG(bx), UNIT_VG(bx), tid);
        int ui = 0;
        for (int u_ = bx; u_ < 4096 * REP_P2; u_ += G, ++ui) { const int u = u_ & 4095;
            const int sub = (wave + ui) & 7;
            const bool hn = (u_ + G) < 4096 * REP_P2; const int un = (u_ + G) & 4095;
            const bf16_t* nkg = hn ? UNIT_KG(un) : nullptr; const bf16_t* nvg = hn ? UNIT_VG(un) : nullptr;
            if (u < 2048) { const int c = 7 - (u >> 8), bh = u & 255;
                att2::moba_unit(bh >> 3, bh & 7, c, sub, QK, VT, kpart, A2, lut + (bh & 7) * 128, kb, ctl, lds, wave, lane, tid, stg, nkg, nvg);
            } else { const int v = u - 2048, qblk = 7 - (v >> 8), bh = v & 255;
                att2::sb_unit(bh >> 3, bh & 7, qblk, sub, QK, VT, A2, ctl, lds, wave, lane, tid, stg, nkg, nvg);
            }
        }
    }
    if constexpr (PH_IN(2) && PH_IN(3)) {
    xcd_barrier(xbar);
    }
    STAMP(3);

    if constexpr (PH_IN(3)) if (bx < NP) { const int pm = bx;
#define P7A_BLOCK { pg8::Gemm g{PB, Wppt, PLE, PLE}; PanelSched S{pm, 4, 0}; EpiPP E{PP}; pg8::gemm_phase<EpiPP, PanelSched, true, true>(lds, g, S, E, wave); chain_fence(); }
        {
            pg8::Gemm g{A2, W3t, 1024, 512}; PanelSched S{pm, 8, 1}; Epi3 E{Gt, MIX};
            pg8::gemm_phase<Epi3, PanelSched, true, true>(lds, g, S, E, wave); chain_fence(); STAMP(4);
        }
        {
            pg8::Gemm g{MIX, Wot, 1024, 1024}; PanelSched S{pm, 4, 0}; EpiRes<0> E{x, nullptr, XB1, ssq1, nullptr, rs};
            pg8::gemm_phase<EpiRes<0>, PanelSched, true, true>(lds, g, S, E, wave); chain_fence(); STAMP(5);
        }
        compute_rs(ssq1, pm, rs, tid);
        for (int rep_ = 0; rep_ < REP_P5; ++rep_)
        {
            pg8::Gemm g{XB1, Wgut, 1024, 1024}; PanelSched S{pm, 22, 0}; Epi5 E{HB, rs};
            pg8::gemm_phase<Epi5, PanelSched, true, true>(lds, g, S, E, wave); chain_fence(); STAMP(6);
        }
        {
            pg8::Gemm g{HB, Wdt, FFH, FFH}; PanelSched S{pm, 4, 0}; EpiRes<2> E{nullptr, XB1, XB2, ssq2, nullptr, rs};
            pg8::gemm_phase<EpiRes<2>, PanelSched, true, true>(lds, g, S, E, wave); chain_fence(); STAMP(7);
        }
        compute_rs(ssq2, pm, rs, tid);
        {
            pg8::Gemm g{XB2, Wpgt, 1024, 1024}; PanelSched S{pm, 4, 0}; EpiRes<1> E{nullptr, XB2, XB3, ssq3, PP, rs};
            pg8::gemm_phase<EpiRes<1>, PanelSched, true, true>(lds, g, S, E, wave); chain_fence(); STAMP(8);
        }
        compute_rs(ssq3, pm, rs, tid);
        {
            const f32x4* fg = (const f32x4*)args.in[17] + lane;
            for (int r = wave; r < 256; r += 8) {
                const size_t ro = (size_t)(pm * 256 + r) * DM; const u32x2* xr = (const u32x2*)(XB3 + ro) + lane; f32x4* pr = (f32x4*)(out + ro) + lane; const float s = rs[r];
#pragma unroll
                for (int j = 0; j < 4; ++j) { const u32x2 t = xr[64 * j]; const f32x4 v = {bflo(t.x), bfhi(t.x), bflo(t.y), bfhi(t.y)}; pr[64 * j] = v * s * fg[64 * j]; }
            }
        }
        __syncthreads();
#if PROBE_T
        if (bx == 0 && tid == 0) out[0] = t_probe;
#endif
    }
}

extern "C" void kernel_launch(void* const* d_in, const int* in_sizes, int n_in, void* d_out, int out_size, void* d_ws, size_t ws_size, hipStream_t stream) {
    static int grid = 0;
    if (grid == 0) {
        if (n_in != 18 || out_size != MTOK * DM || ws_size < WS_END) { fprintf(stderr, "kernel_launch: unexpected problem shape (n_in %d, out %d, ws %zu)\n", n_in, out_size, ws_size); grid = -1; return; }
        int dev = 0, cus = 0, per_cu = 0;
        hipGetDevice(&dev); hipDeviceGetAttribute(&cus, hipDeviceAttributeMultiprocessorCount, dev);
        if (hipFuncSetAttribute((const void*)fwd_megakernel<0, 4>, hipFuncAttributeMaxDynamicSharedMemorySize, LDS_BYTES) != hipSuccess) fprintf(stderr, "kernel_launch: hipFuncSetAttribute failed\n");
        if (hipOccupancyMaxActiveBlocksPerMultiprocessor(&per_cu, (const void*)fwd_megakernel<0, 4>, 512, LDS_BYTES) != hipSuccess || per_cu < 1) { fprintf(stderr, "kernel_launch: occupancy query says %d\n", per_cu); per_cu = 1; }
        (void)hipGetLastError();
        if (N_LAUNCHES == 1 && cus * per_cu < NP) { fprintf(stderr, "kernel_launch: needs %d co-resident workgroups, device holds %d\n", NP, cus * per_cu); }
        grid = NP;
    }
    if (grid < 0) return;
    if (hipMemsetAsync((char*)d_ws + WS_RSTD0 + 512 * 1024, 0, 16384, stream) != hipSuccess) fprintf(stderr, "kernel_launch: hipMemsetAsync failed\n");
    Args a{};
    for (int i = 0; i < 18; ++i) a.in[i] = (const float*)d_in[i];
    a.out = (float*)d_out; a.ws = (unsigned char*)d_ws;
    hipError_t e = hipSuccess;
#if N_LAUNCHES == 1
    void* kargs[] = {&a};
    e = hipLaunchCooperativeKernel((const void*)fwd_megakernel<0, 4>, dim3(grid), dim3(512), kargs, LDS_BYTES, stream);
#else
    hipFuncSetAttribute((const void*)fwd_megakernel<0, 1>, hipFuncAttributeMaxDynamicSharedMemorySize, LDS_BYTES); hipFuncSetAttribute((const void*)fwd_megakernel<1, 2>, hipFuncAttributeMaxDynamicSharedMemorySize, LDS_BYTES);
    hipFuncSetAttribute((const void*)fwd_megakernel<2, 3>, hipFuncAttributeMaxDynamicSharedMemorySize, LDS_BYTES); hipFuncSetAttribute((const void*)fwd_megakernel<3, 4>, hipFuncAttributeMaxDynamicSharedMemorySize, LDS_BYTES);
    for (int r_ = 0; r_ < N_LAUNCHES - 3; ++r_) hipLaunchKernelGGL((fwd_megakernel<0, 1>), dim3(grid), dim3(512), LDS_BYTES, stream, a);
    hipLaunchKernelGGL((fwd_megakernel<1, 2>), dim3(grid), dim3(512), LDS_BYTES, stream, a);
    hipLaunchKernelGGL((fwd_megakernel<2, 3>), dim3(grid), dim3(512), LDS_BYTES, stream, a); hipLaunchKernelGGL((fwd_megakernel<3, 4>), dim3(grid), dim3(512), LDS_BYTES, stream, a);
    e = hipPeekAtLastError();
#endif
    if (e != hipSuccess) fprintf(stderr, "kernel_launch: cooperative launch failed: %s (grid %d)\n", hipGetErrorString(e), grid);
}
```

```cpp
#include <hip/hip_runtime.h>
#include <hip/hip_cooperative_groups.h>
#include <cstdio>
#include <cstdint>
#include <cmath>
namespace cg = cooperative_groups;

#ifndef N_LAUNCHES
#define N_LAUNCHES 1
#endif
#ifndef REP_P0
#define REP_P0 1
#endif
#ifndef REP_P1
#define REP_P1 1
#endif
#ifndef REP_P2
#define REP_P2 1
#endif
#ifndef REP_P5
#define REP_P5 1
#endif
#ifndef PROBE_T
#define PROBE_T 0
#endif
#ifndef DBG_NO_SB
#define DBG_NO_SB 0
#endif
#ifndef DBG_NO_MOBA
#define DBG_NO_MOBA 0
#endif

namespace pg8 {
#define PG8_LAS __attribute__((address_space(3)))
typedef unsigned short bf16_t;
typedef short bf16x8 __attribute__((ext_vector_type(8)));
typedef float f32x4 __attribute__((ext_vector_type(4)));
typedef unsigned u32x4 __attribute__((ext_vector_type(4)));
typedef unsigned u32x2 __attribute__((ext_vector_type(2)));
constexpr int BM = 256, BK = 64, HALF = 128, HTB = HALF * BK * 2  , STAGE_BYTES = 8 * HTB;

__host__ __device__ __forceinline__ int lds_byte(int r, int c) { const int st = (r >> 4) * 2 + (c >> 5), rr = r & 15, cc = c & 31, ob = rr * 64 + cc * 2; return st * 1024 + (ob ^ (((ob >> 9) & 1) << 5)); }
__host__ __device__ __forceinline__ void stage_rc(int b, int& R, int& C) { const int st = b / 1024, sb = b % 1024, swz = sb ^ (((sb >> 9) & 1) << 5); R = (st >> 1) * 16 + swz / 64; C = (st & 1) * 32 + (swz % 64) / 2; }
__host__ __device__ __forceinline__ int perm32(int rho) { const int n = rho >> 4, i = rho & 15; return 8 * (i >> 2) + 4 * n + (i & 3); }

struct Unit { int pm, pn, ka; };
struct Gemm { const bf16_t* A; const bf16_t* Bt; int lda, K; };

typedef float f32x2_t __attribute__((ext_vector_type(2))); typedef __bf16 bf16x2_t __attribute__((ext_vector_type(2)));
__device__ __forceinline__ unsigned cvt_pk_bf16(float lo, float hi) { f32x2_t v = {lo, hi}; bf16x2_t b = __builtin_convertvector(v, bf16x2_t); return __builtin_bit_cast(unsigned, b); }
__device__ __forceinline__ float bflo(unsigned w) { return __uint_as_float(w << 16); }
__device__ __forceinline__ float bfhi(unsigned w) { return __uint_as_float(w & 0xffff0000u); }
__device__ __forceinline__ float sigm(float x) { return __builtin_amdgcn_rcpf(1.f + __expf(-x)); }
__device__ __forceinline__ u32x4 pack8(f32x4 a, f32x4 b) { u32x4 w; w.x = cvt_pk_bf16(a[0], a[1]); w.y = cvt_pk_bf16(a[2], a[3]); w.z = cvt_pk_bf16(b[0], b[1]); w.w = cvt_pk_bf16(b[2], b[3]); return w; }

template <class Epi, class Sched, bool ALIGN_EPI = false, bool SP2 = false>
__device__ __forceinline__ void gemm_phase(PG8_LAS unsigned char* lds, const Gemm g, const Sched& S, const Epi& E, const int wave_s) {
    int tid_; asm volatile("v_mbcnt_lo_u32_b32 %0, -1, 0\n\tv_mbcnt_hi_u32_b32 %0, -1, %0" : "=v"(tid_)); tid_ += 64 * wave_s;
    const int tid = tid_, wid = __builtin_amdgcn_readfirstlane(tid >> 6), lane = tid & 63, wr = wid >> 2, wc = wid & 3, fr = lane & 15, fq = lane >> 4;
    const int K = g.K, nt = K / BK;
    unsigned voffA[2], voffB[2];
#pragma unroll
    for (int i = 0; i < 2; ++i) { int R, C; stage_rc(tid * 16 + i * 8192, R, C); const int Rb = Epi::PERM ? ((R & ~31) + perm32(R & 31)) : R;
        voffA[i] = (unsigned)(R * g.lda + C) * 2u; voffB[i] = (unsigned)(Rb * K + C) * 2u; }
    const size_t kstep = (size_t)(BK * 2);
    const size_t hstepA = (size_t)HALF * g.lda * 2, hstepB = (size_t)HALF * K * 2;
    const size_t tstepA = 2 * hstepA, tstepB = 2 * hstepB;
    const unsigned ldsw = (unsigned)wid * 1024u;
    const int aoff = lds_byte(wr * 64 + fr, fq * 8), boff = lds_byte(wc * 32 + fr, fq * 8);
#define PG8_SA(b, h) (((b) * 2 + (h)) * HTB)
#define PG8_SB(b, h) ((4 + (b) * 2 + (h)) * HTB)
#define PG8_STAGE(bufoff, gbase, voff) do { _Pragma("unroll") for (int _i = 0; _i < 2; ++_i) \
        __builtin_amdgcn_global_load_lds((const unsigned*)((const char*)(gbase) + (voff)[_i]), (PG8_LAS unsigned*)(lds + (bufoff) + ldsw + _i * 8192), 16, 0, 0); } while (0)
#define PG8_LDA(dst, b, h) do { _Pragma("unroll") for (int m = 0; m < 4; ++m) _Pragma("unroll") for (int k = 0; k < 2; ++k) dst[m][k] = *(const PG8_LAS bf16x8*)(lds + PG8_SA(b, h) + aoff + m * 2048 + k * 1024); } while (0)
#define PG8_LDB(dst, b, h) do { _Pragma("unroll") for (int n = 0; n < 2; ++n) _Pragma("unroll") for (int k = 0; k < 2; ++k) dst[n][k] = *(const PG8_LAS bf16x8*)(lds + PG8_SB(b, h) + boff + n * 2048 + k * 1024); } while (0)
#define PG8_MMA(ai, bj, At, Bt) do { __builtin_amdgcn_s_setprio(1); _Pragma("unroll") for (int m = 0; m < 4; ++m) _Pragma("unroll") for (int n = 0; n < 2; ++n) _Pragma("unroll") for (int k = 0; k < 2; ++k) \
        acc[ai][bj][m][n] = __builtin_amdgcn_mfma_f32_16x16x32_bf16(Bt[n][k], At[m][k], acc[ai][bj][m][n], 0, 0, 0); __builtin_amdgcn_s_setprio(0); } while (0)
#define PG8_WAIT_V(n) asm volatile("s_waitcnt vmcnt(" #n ")" ::: "memory")
#define PG8_WAIT_L(n) asm volatile("s_waitcnt lgkmcnt(" #n ")" ::: "memory")
#define PG8_BAR __builtin_amdgcn_s_barrier()
#define PG8_SCHED __builtin_amdgcn_sched_barrier(0)
    Unit cur, nxt; int ui = 0;
    if (!S.next(0, cur)) return;
    f32x4 acc[2][2][4][2];
#pragma unroll
    for (int a = 0; a < 2; ++a)
#pragma unroll
        for (int b = 0; b < 2; ++b)
#pragma unroll
            for (int m = 0; m < 4; ++m)
#pragma unroll
                for (int n = 0; n < 2; ++n) acc[a][b][m][n] = (f32x4){0.f, 0.f, 0.f, 0.f};
    bf16x8 At[4][2], B0[2][2], B1[2][2];
    const char* cA = (const char*)g.A + (size_t)cur.pm * tstepA + (size_t)cur.ka * 2; const char* cB = (const char*)g.Bt + (size_t)cur.pn * tstepB;
    if constexpr (SP2) {
        PG8_STAGE(PG8_SB(0, 0), cB, voffB); PG8_STAGE(PG8_SB(0, 1), cB + hstepB, voffB); PG8_STAGE(PG8_SA(0, 0), cA, voffA); PG8_STAGE(PG8_SA(0, 1), cA + hstepA, voffA);
        if (wr == 1) PG8_BAR;
        PG8_WAIT_V(2); PG8_BAR;
        PG8_STAGE(PG8_SB(1, 0), cB + kstep, voffB); PG8_STAGE(PG8_SA(1, 0), cA + kstep, voffA); PG8_STAGE(PG8_SB(1, 1), cB + hstepB + kstep, voffB);
        PG8_WAIT_V(6); PG8_BAR;
    } else {
        PG8_STAGE(PG8_SB(0, 0), cB, voffB); PG8_STAGE(PG8_SA(0, 0), cA, voffA); PG8_STAGE(PG8_SB(0, 1), cB + hstepB, voffB); PG8_STAGE(PG8_SA(0, 1), cA + hstepA, voffA);
        if (wr == 1) PG8_BAR;
        PG8_WAIT_V(4); PG8_BAR;
        PG8_STAGE(PG8_SB(1, 0), cB + kstep, voffB); PG8_STAGE(PG8_SA(1, 0), cA + kstep, voffA); PG8_STAGE(PG8_SB(1, 1), cB + hstepB + kstep, voffB);
        PG8_WAIT_V(6); PG8_BAR;
    }
    for (;;) {
        const bool has_next = S.next(ui + 1, nxt);
        const char* nA = has_next ? (const char*)g.A + (size_t)nxt.pm * tstepA + (size_t)nxt.ka * 2 : cA; const char* nB = has_next ? (const char*)g.Bt + (size_t)nxt.pn * tstepB : cB;
        for (int t = 0; t < nt; t += 2) {
            const bool last = (t == nt - 2);
            const char* a1 = cA + (size_t)(t + 1) * kstep;
            const char* a2 = last ? nA : cA + (size_t)(t + 2) * kstep; const char* b2 = last ? nB : cB + (size_t)(t + 2) * kstep;
            const char* a3 = a2 + kstep; const char* b3 = b2 + kstep;
            if constexpr (SP2) {
            PG8_LDB(B0, 0, 0); PG8_LDB(B1, 0, 1); PG8_SCHED; PG8_LDA(At, 0, 0); PG8_STAGE(PG8_SA(1, 1), a1 + hstepA, voffA);
            PG8_WAIT_V(8); PG8_WAIT_L(0); PG8_BAR; PG8_MMA(0, 0, At, B0); PG8_MMA(0, 1, At, B1); PG8_BAR; PG8_SCHED;
            PG8_LDA(At, 0, 1); PG8_STAGE(PG8_SB(0, 0), b2, voffB); PG8_STAGE(PG8_SB(0, 1), b2 + hstepB, voffB); PG8_STAGE(PG8_SA(0, 0), a2, voffA);
            PG8_WAIT_V(8); PG8_WAIT_L(0); PG8_BAR; PG8_MMA(1, 0, At, B0); PG8_MMA(1, 1, At, B1); PG8_BAR; PG8_SCHED;
            PG8_LDB(B0, 1, 0); PG8_LDB(B1, 1, 1); PG8_SCHED; PG8_LDA(At, 1, 0); PG8_STAGE(PG8_SA(0, 1), a2 + hstepA, voffA);
            PG8_WAIT_V(8); PG8_WAIT_L(0); PG8_BAR; PG8_MMA(0, 0, At, B0); PG8_MMA(0, 1, At, B1); PG8_BAR; PG8_SCHED;
            PG8_LDA(At, 1, 1); PG8_STAGE(PG8_SB(1, 0), b3, voffB); PG8_STAGE(PG8_SB(1, 1), b3 + hstepB, voffB); PG8_STAGE(PG8_SA(1, 0), a3, voffA);
            PG8_WAIT_V(8); PG8_WAIT_L(0); PG8_BAR; PG8_MMA(1, 0, At, B0); PG8_MMA(1, 1, At, B1); PG8_BAR; PG8_SCHED;
            } else {
            PG8_LDB(B0, 0, 0); PG8_SCHED; PG8_LDA(At, 0, 0); PG8_STAGE(PG8_SA(1, 1), a1 + hstepA, voffA);
            PG8_WAIT_L(8); PG8_BAR; PG8_WAIT_L(0); PG8_MMA(0, 0, At, B0); PG8_BAR; PG8_SCHED;
            PG8_LDB(B1, 0, 1); PG8_STAGE(PG8_SB(0, 0), b2, voffB);
            PG8_BAR; PG8_WAIT_L(0); PG8_MMA(0, 1, At, B1); PG8_BAR;
            PG8_LDA(At, 0, 1); PG8_STAGE(PG8_SA(0, 0), a2, voffA);
            PG8_BAR; PG8_WAIT_L(0); PG8_MMA(1, 0, At, B0); PG8_BAR; PG8_SCHED;
            PG8_STAGE(PG8_SB(0, 1), b2 + hstepB, voffB);
            PG8_WAIT_V(6); PG8_BAR; PG8_MMA(1, 1, At, B1); PG8_BAR;
            PG8_LDB(B0, 1, 0); PG8_SCHED; PG8_LDA(At, 1, 0); PG8_STAGE(PG8_SA(0, 1), a2 + hstepA, voffA);
            PG8_WAIT_L(8); PG8_BAR; PG8_WAIT_L(0); PG8_MMA(0, 0, At, B0); PG8_BAR; PG8_SCHED;
            PG8_LDB(B1, 1, 1); PG8_STAGE(PG8_SB(1, 0), b3, voffB);
            PG8_BAR; PG8_WAIT_L(0); PG8_MMA(0, 1, At, B1); PG8_BAR;
            PG8_LDA(At, 1, 1); PG8_STAGE(PG8_SA(1, 0), a3, voffA);
            PG8_BAR; PG8_WAIT_L(0); PG8_MMA(1, 0, At, B0); PG8_BAR; PG8_SCHED;
            PG8_STAGE(PG8_SB(1, 1), b3 + hstepB, voffB);
            PG8_WAIT_V(6); PG8_BAR; PG8_MMA(1, 1, At, B1); PG8_BAR;
            }
        }
        if constexpr (ALIGN_EPI) { if (wr == 0) PG8_BAR; }
        const bool keep = E(acc, cur, wr, wc, fr, fq);
        if (!has_next) break;
        if (!keep) {
#pragma unroll
        for (int a = 0; a < 2; ++a)
#pragma unroll
            for (int b = 0; b < 2; ++b)
#pragma unroll
                for (int m = 0; m < 4; ++m)
#pragma unroll
                    for (int n = 0; n < 2; ++n) acc[a][b][m][n] = (f32x4){0.f, 0.f, 0.f, 0.f};
        }
        cur = nxt; cA = nA; cB = nB; ++ui;
        if constexpr (ALIGN_EPI) { if (wr == 1) PG8_BAR; }
    }
    PG8_WAIT_V(0);
    if constexpr (!ALIGN_EPI) { if (wr == 0) PG8_BAR; }
    PG8_BAR;
#undef PG8_SA
#undef PG8_SB
#undef PG8_STAGE
#undef PG8_LDA
#undef PG8_LDB
#undef PG8_MMA
#undef PG8_WAIT_V
#undef PG8_WAIT_L
#undef PG8_BAR
#undef PG8_SCHED
}
}

using pg8::bf16_t; using pg8::f32x4; using pg8::u32x4; using pg8::u32x2; using pg8::Unit; using pg8::cvt_pk_bf16; using pg8::bflo; using pg8::bfhi; using pg8::sigm; using pg8::pack8;
#define LAS __attribute__((address_space(3)))

constexpr int NB = 32, SEQ = 2048, DM = 1024, MTOK = NB * SEQ, NP = MTOK / 256;
constexpr int FFH = 2816, PLE = 256;
constexpr float EPS = 1e-6f, LOG2E = 1.4426950408889634f;

constexpr size_t MiB = 1u << 20;
constexpr size_t WS_RSTD0 = 0, WS_KPART = 1 * MiB;
constexpr size_t WS_W1T = 2 * MiB, WS_WVT = 10 * MiB, WS_W3T = 12 * MiB, WS_WOT = 14 * MiB, WS_WGUT = 16 * MiB, WS_WDT = 27 * MiB, WS_WPGT = 33 * MiB, WS_WPPT = 35 * MiB;
constexpr size_t WS_SSQ1 = 36 * MiB, WS_SSQ2 = 40 * MiB, WS_SSQ3 = 44 * MiB;
constexpr size_t WS_PB = 48 * MiB;
constexpr size_t WS_XB = 80 * MiB;
constexpr size_t WS_QK = 208 * MiB;
constexpr size_t WS_VT = 464 * MiB;
constexpr size_t WS_H = 208 * MiB;
constexpr size_t WS_GT = 592 * MiB;
constexpr size_t WS_A2 = 848 * MiB;
constexpr size_t WS_END = 976 * MiB;
static_assert(WS_H + (size_t)MTOK * FFH * 2 <= WS_GT && WS_VT + (size_t)MTOK * 512 * 2 * 2 <= WS_GT, "ws map");

constexpr int RING_BYTES = 131072, RS_OFF = RING_BYTES, LDS_BYTES = 152 * 1024;

struct PanelSched {
    int pm, n, mode;
    __device__ __forceinline__ bool next(int i, Unit& u) const {
        if (i >= n) return false;
        if (mode == 0) { u.pm = pm; u.pn = i; u.ka = 0; }
        else if (mode == 2) { u.pm = i; u.pn = pm; u.ka = 0; }
        else { const int pass = i & 1; u.pm = pm; u.pn = (i >> 1) + 4 * pass; u.ka = 512 * pass; }
        return true;
    }
};

struct XcdOrder {
    int nM, nN, nwg, G, c, W;
    __device__ __forceinline__ void init(int nM_, int nN_, int G_, int c_, int W_ = 8) { nM = nM_; nN = nN_; nwg = nM * nN; G = G_; c = c_; W = W_; }
    __device__ __forceinline__ bool next(int i, Unit& u) const {
        const long L = (long)i * G + c; if (L >= nwg) return false;
        int wgid = (int)L; { const int q = nwg / 8, r = nwg % 8, xcd = wgid % 8, off = wgid / 8; wgid = (xcd < r ? xcd * (q + 1) : r * (q + 1) + (xcd - r) * q) + off; }
        const int nig = W * nN, gid = wgid / nig, fm = gid * W, gsz = (nM - fm) < W ? (nM - fm) : W;
        u.pm = fm + ((wgid % nig) % gsz); u.pn = (wgid % nig) / gsz; u.ka = 0; return true;
    }
};

struct Epi1 {
    static constexpr bool PERM = true;
    const float* rstd0; const float* bgate; bf16_t* QK; bf16_t* Gt; float* kpart;
    __device__ __forceinline__ bool operator()(f32x4 (&acc)[2][2][4][2], const Unit& u, int wr, int wc, int fr_, int fq_) const {
        int fr = fr_, fq = fq_; asm volatile("" : "+v"(fr), "+v"(fq));
        const int rowl = wr * 64 + fr, row0 = u.pm * 256 + rowl, lc0 = wc * 32 + 8 * fq, pn = u.pn;
        float rs[2][4];
#pragma unroll
        for (int ai = 0; ai < 2; ++ai)
#pragma unroll
            for (int m = 0; m < 4; ++m) rs[ai][m] = rstd0[row0 + ai * 128 + m * 16];
        if (pn < 8) {
            const int cb = pn * 256 + lc0;
#pragma unroll
            for (int ai = 0; ai < 2; ++ai)
#pragma unroll
                for (int m = 0; m < 4; ++m) {
                    bf16_t* rowp = QK + (size_t)(row0 + ai * 128 + m * 16) * 2048 + cb; const float r = rs[ai][m];
#pragma unroll
                    for (int bj = 0; bj < 2; ++bj) *(u32x4*)(rowp + bj * 128) = pack8(acc[ai][bj][m][0] * r, acc[ai][bj][m][1] * r);
                }
            if (pn >= 6) {
#pragma unroll
                for (int bj = 0; bj < 2; ++bj)
#pragma unroll
                    for (int n = 0; n < 2; ++n)
#pragma unroll
                        for (int j = 0; j < 4; ++j) {
                            float s = 0.f;
#pragma unroll
                            for (int ai = 0; ai < 2; ++ai)
#pragma unroll
                                for (int m = 0; m < 4; ++m) s += acc[ai][bj][m][n][j] * rs[ai][m];
                            s += __shfl_xor(s, 1); s += __shfl_xor(s, 2); s += __shfl_xor(s, 4); s += __shfl_xor(s, 8);
                            if (fr == 0) kpart[(size_t)(u.pm * 2 + wr) * 512 + (pn & 1) * 256 + bj * 128 + lc0 + 4 * n + j] = s;
                        }
            }
        } else {
            const int gc = (pn - 8) * 256 + lc0;
            f32x4 bv[2][2];
#pragma unroll
            for (int bj = 0; bj < 2; ++bj)
#pragma unroll
                for (int n = 0; n < 2; ++n) bv[bj][n] = *(const f32x4*)(bgate + gc + bj * 128 + 4 * n);
#pragma unroll
            for (int ai = 0; ai < 2; ++ai)
#pragma unroll
                for (int m = 0; m < 4; ++m) {
                    bf16_t* rowp = Gt + (size_t)(row0 + ai * 128 + m * 16) * 2048 + gc; const float r = rs[ai][m];
#pragma unroll
                    for (int bj = 0; bj < 2; ++bj) {
                        f32x4 v0 = acc[ai][bj][m][0] * r + bv[bj][0], v1 = acc[ai][bj][m][1] * r + bv[bj][1];
#pragma unroll
                        for (int j = 0; j < 4; ++j) { v0[j] = sigm(v0[j]); v1[j] = sigm(v1[j]); }
                        *(u32x4*)(rowp + bj * 128) = pack8(v0, v1);
                    }
                }
        }
        return false;
    }
};

struct EpiVT {
    static constexpr bool PERM = true;
    const float* rstd0; bf16_t* VT;
    __device__ __forceinline__ bool operator()(f32x4 (&acc)[2][2][4][2], const Unit& u, int wr, int wc, int fr_, int fq_) const {
        int fr = fr_, fq = fq_; asm volatile("" : "+v"(fr), "+v"(fq));
        const int b = u.pn >> 3, t0 = (u.pn & 7) * 256 + wc * 32 + 8 * fq;
        f32x4 rv[2][2];
#pragma unroll
        for (int bj = 0; bj < 2; ++bj)
#pragma unroll
            for (int n = 0; n < 2; ++n) rv[bj][n] = *(const f32x4*)(rstd0 + (size_t)b * SEQ + t0 + bj * 128 + 4 * n);
#pragma unroll
        for (int ai = 0; ai < 2; ++ai)
#pragma unroll
            for (int m = 0; m < 4; ++m) {
                const int vr = u.pm * 256 + ai * 128 + wr * 64 + m * 16 + fr;
                bf16_t* rowp = VT + ((size_t)(((vr >> 9) * 32 + b) * 512 + (vr & 511))) * 2048 + t0;
#pragma unroll
                for (int bj = 0; bj < 2; ++bj) *(u32x4*)(rowp + bj * 128) = pack8(acc[ai][bj][m][0] * rv[bj][0], acc[ai][bj][m][1] * rv[bj][1]);
            }
        return false;
    }
};

struct Epi3 {
    static constexpr bool PERM = true;
    const bf16_t* Gt; bf16_t* mix;
    __device__ __forceinline__ bool operator()(f32x4 (&acc)[2][2][4][2], const Unit& u, int wr, int wc, int fr_, int fq_) const {
        int fr = fr_, fq = fq_; asm volatile("" : "+v"(fr), "+v"(fq));
        const int pass = u.pn >> 2, nc = (u.pn & 3) * 256 + wc * 32 + 8 * fq, row0 = u.pm * 256 + wr * 64 + fr;
#pragma unroll
        for (int ai = 0; ai < 2; ++ai)
#pragma unroll
            for (int m = 0; m < 4; ++m) {
                const size_t row = (size_t)(row0 + ai * 128 + m * 16); const bf16_t* gp = Gt + row * 2048 + nc + pass * 1024;
#pragma unroll
                for (int bj = 0; bj < 2; ++bj) {
                    const u32x4 gg = *(const u32x4*)(gp + bj * 128);
                    const f32x4 g0 = {bflo(gg.x), bfhi(gg.x), bflo(gg.y), bfhi(gg.y)}, g1 = {bflo(gg.z), bfhi(gg.z), bflo(gg.w), bfhi(gg.w)};
                    f32x4 v0 = acc[ai][bj][m][0] * g0, v1 = acc[ai][bj][m][1] * g1;
                    u32x4* mp = (u32x4*)(mix + row * 1024 + nc + bj * 128);
                    if (pass == 1) { const u32x4 t = *mp;
                        v0 += (f32x4){bflo(t.x), bfhi(t.x), bflo(t.y), bfhi(t.y)}; v1 += (f32x4){bflo(t.z), bfhi(t.z), bflo(t.w), bfhi(t.w)}; }
                    *mp = pack8(v0, v1);
                }
            }
        return false;
    }
};

template <int MODE> struct EpiRes {
    static constexpr bool PERM = true;
    const float* base; const bf16_t* baseb; bf16_t* xb; float* ssq; const bf16_t* PP; const LAS float* rs;
    __device__ __forceinline__ bool operator()(f32x4 (&acc)[2][2][4][2], const Unit& u, int wr, int wc, int fr_, int fq_) const {
        int fr = fr_, fq = fq_; asm volatile("" : "+v"(fr), "+v"(fq));
        const int rl = wr * 64 + fr, c0 = u.pn * 256 + wc * 32 + 8 * fq;
#pragma unroll
        for (int ai = 0; ai < 2; ++ai)
#pragma unroll
            for (int m = 0; m < 4; ++m) {
                const int rloc = ai * 128 + m * 16 + rl; const size_t row = (size_t)u.pm * 256 + rloc; float ss = 0.f; const float r = MODE == 1 ? rs[rloc] : 0.f;
#pragma unroll
                for (int bj = 0; bj < 2; ++bj) {
                    const size_t off = row * 1024 + c0 + bj * 128; f32x4 b0, b1, v0, v1;
                    if (MODE == 0) { b0 = *(const f32x4*)(base + off); b1 = *(const f32x4*)(base + off + 4); }
                    else { const u32x4 t = *(const u32x4*)(baseb + off); b0 = (f32x4){bflo(t.x), bfhi(t.x), bflo(t.y), bfhi(t.y)}; b1 = (f32x4){bflo(t.z), bfhi(t.z), bflo(t.w), bfhi(t.w)}; }
                    if (MODE != 1) { v0 = b0 + acc[ai][bj][m][0]; v1 = b1 + acc[ai][bj][m][1]; }
                    else { const u32x4 t = *(const u32x4*)(PP + off + row * 1024);
                        const f32x4 p0 = {bflo(t.x), bfhi(t.x), bflo(t.y), bfhi(t.y)}, p1 = {bflo(t.z), bfhi(t.z), bflo(t.w), bfhi(t.w)};
                        f32x4 a0 = acc[ai][bj][m][0] * r, a1 = acc[ai][bj][m][1] * r;
#pragma unroll
                        for (int j = 0; j < 4; ++j) { a0[j] = sigm(a0[j]); a1[j] = sigm(a1[j]); }
                        v0 = b0 + a0 * p0; v1 = b1 + a1 * p1; }
                    ss += ((v0[0] * v0[0] + v0[1] * v0[1]) + (v0[2] * v0[2] + v0[3] * v0[3])) + ((v1[0] * v1[0] + v1[1] * v1[1]) + (v1[2] * v1[2] + v1[3] * v1[3]));
                    *(u32x4*)(xb + off) = pack8(v0, v1);
                }
                ss += __shfl_xor(ss, 16); ss += __shfl_xor(ss, 32);
                if (fq == 0) ssq[row * 16 + u.pn * 4 + wc] = ss;
            }
        return false;
    }
};

struct Epi5 {
    static constexpr bool PERM = true;
    bf16_t* H; const LAS float* rs;
    __device__ __forceinline__ bool operator()(f32x4 (&acc)[2][2][4][2], const Unit& u, int wr, int wc, int fr_, int fq_) const {
        int fr = fr_, fq = fq_; asm volatile("" : "+v"(fr), "+v"(fq));
        const int rl = wr * 64 + fr, hc = u.pn * 128 + wc * 32 + 8 * fq;
#pragma unroll
        for (int ai = 0; ai < 2; ++ai)
#pragma unroll
            for (int m = 0; m < 4; ++m) {
                const int rloc = ai * 128 + m * 16 + rl; const size_t row = (size_t)u.pm * 256 + rloc; const float r = rs[rloc];
                f32x4 h[2];
#pragma unroll
                for (int n = 0; n < 2; ++n) { const f32x4 g = acc[ai][0][m][n] * r, up = acc[ai][1][m][n] * r;
#pragma unroll
                    for (int j = 0; j < 4; ++j) h[n][j] = g[j] * sigm(g[j]) * up[j]; }
                __builtin_nontemporal_store(pack8(h[0], h[1]), (u32x4*)(H + row * FFH + hc));
            }
        return false;
    }
};

struct EpiPP {
    static constexpr bool PERM = true;
    bf16_t* out;
    __device__ __forceinline__ bool operator()(f32x4 (&acc)[2][2][4][2], const Unit& u, int wr, int wc, int fr_, int fq_) const {
        int fr = fr_, fq = fq_; asm volatile("" : "+v"(fr), "+v"(fq));
        const int rl = wr * 64 + fr, c0 = u.pn * 256 + wc * 32 + 8 * fq;
#pragma unroll
        for (int ai = 0; ai < 2; ++ai)
#pragma unroll
            for (int m = 0; m < 4; ++m) { const size_t row = (size_t)u.pm * 256 + ai * 128 + m * 16 + rl;
#pragma unroll
                for (int bj = 0; bj < 2; ++bj) *(u32x4*)(out + row * 2048 + c0 + bj * 128) = pack8(acc[ai][bj][m][0], acc[ai][bj][m][1]); }
        return false;
    }
};

namespace att {
typedef short bf16x8 __attribute__((ext_vector_type(8)));
typedef float f32x16 __attribute__((ext_vector_type(16)));
#define MFMA32(a, b, c) __builtin_amdgcn_mfma_f32_32x32x16_bf16((a), (b), (c), 0, 0, 0)
__device__ __forceinline__ int swap23(int r) { return (r & 0x13) | ((r & 4) << 1) | ((r & 8) >> 1); }
__device__ __forceinline__ float bf2f(short b) { return __uint_as_float(((unsigned)(unsigned short)b) << 16); }
__device__ __forceinline__ bf16x8 pack8f(const float* p) {
    u32x4 w; w.x = cvt_pk_bf16(p[0], p[1]); w.y = cvt_pk_bf16(p[2], p[3]); w.z = cvt_pk_bf16(p[4], p[5]); w.w = cvt_pk_bf16(p[6], p[7]);
    return __builtin_bit_cast(bf16x8, w);
}
struct Frag { bf16x8 k[4]; bf16x8 v[2][2]; };
__device__ __forceinline__ void load_tile(Frag& f, const bf16_t* kp, const bf16_t* vp) {
#pragma unroll
    for (int s = 0; s < 4; ++s) f.k[s] = *(const bf16x8*)(kp + 16 * s);
#pragma unroll
    for (int dt = 0; dt < 2; ++dt)
#pragma unroll
        for (int g = 0; g < 2; ++g) f.v[dt][g] = *(const bf16x8*)(vp + (size_t)dt * 32 * 2048 + 16 * g);
}
__device__ __forceinline__ void store_o(bf16_t* op, const f32x16& o0, const f32x16& o1, float inv) {
    float t[8];
#pragma unroll
    for (int g = 0; g < 2; ++g) {
#pragma unroll
        for (int e = 0; e < 8; ++e) t[e] = o0[8 * g + e] * inv;
        *(bf16x8*)(op + 16 * g) = pack8f(t);
#pragma unroll
        for (int e = 0; e < 8; ++e) t[e] = o1[8 * g + e] * inv;
        *(bf16x8*)(op + 32 + 16 * g) = pack8f(t);
    }
}

__device__ __forceinline__ void moba_wave(int b, int h, int c, int sub, const bf16_t* QK, const bf16_t* VT, const float* kpart, bf16_t* O,
                                          const LAS float* lut, LAS float* kb, int lane) {
    const int ql = lane & 31, hi = lane >> 5;
    const int tq = c * 256 + sub * 32 + ql;
    const size_t qrow = (size_t)b * SEQ + tq;
    { float ka[7], kc[7];
#pragma unroll
      for (int j = 0; j < 7; ++j) { const float* kp = kpart + (size_t)((b * 8 + (j < c ? j : 0)) * 2) * 512 + h * 64 + lane; ka[j] = kp[0]; kc[j] = kp[512]; }
#pragma unroll
      for (int j = 0; j < 7; ++j) if (j < c) kb[j * 64 + lane] = (ka[j] + kc[j]) * (1.f / 256.f); }
    asm volatile("s_waitcnt lgkmcnt(0)" ::: "memory");
    bf16x8 qf[4];
    { const bf16_t* qp = QK + qrow * 2048 + 1024 + h * 64 + 8 * hi;
#pragma unroll
      for (int s = 0; s < 4; ++s) qf[s] = *(const bf16x8*)(qp + 16 * s); }
    unsigned sel;
    if (c <= 3) sel = (1u << c) - 1u;
    else {
        float g[7];
#pragma unroll
        for (int j = 0; j < 7; ++j) {
            float a = -INFINITY;
            if (j < c) {
                a = 0.f;
#pragma unroll
                for (int s = 0; s < 4; ++s)
#pragma unroll
                    for (int e = 0; e < 8; ++e) a += bf2f(qf[s][e]) * kb[j * 64 + 16 * s + 8 * hi + e];
                a += __shfl_xor(a, 32);
            }
            g[j] = a;
        }
        sel = 0u;
#pragma unroll
        for (int k = 0; k < 3; ++k) {
            float best = -INFINITY; int bi = 0;
#pragma unroll
            for (int j = 0; j < 7; ++j) { const bool t = !((sel >> j) & 1u) && g[j] > best; best = t ? g[j] : best; bi = t ? j : bi; }
            sel |= 1u << bi;
        }
    }
    unsigned rem = 0u;
    for (int j = 0; j < c; ++j) if (__ballot((sel >> j) & 1u) != 0ull) rem |= 1u << j;
    rem = __builtin_amdgcn_readfirstlane(rem);

    const float c2 = 0.125f * LOG2E, bfar = lut[127];
    f32x16 o0, o1;
#pragma unroll
    for (int r = 0; r < 16; ++r) { o0[r] = 0.f; o1[r] = 0.f; }
    float m_run = -INFINITY, l_run = 0.f;
    const bf16_t* kbase = QK + (size_t)b * SEQ * 2048 + 1536 + h * 64 + 8 * hi + (size_t)swap23(ql) * 2048;
    const bf16_t* vbase = VT + ((size_t)((32 + b) * 8 + h) * 64 + swap23(ql)) * 2048 + 8 * hi;
    int tok = c * 256; bool in_own = true;
    Frag cur, nxt;
    load_tile(cur, kbase + (size_t)tok * 2048, vbase + tok);
    for (;;) {
        int tokn = tok; bool has_next = true;
        if (in_own && tok < c * 256 + sub * 32) tokn = tok + 32;
        else if (!in_own && (tok & 255) != 224) tokn = tok + 32;
        else if (rem) { const int j = __builtin_ctz(rem); rem &= rem - 1u; tokn = j * 256; }
        else has_next = false;
        if (has_next) load_tile(nxt, kbase + (size_t)tokn * 2048, vbase + tokn);
        {
            const int jb = tok >> 8; const bool own = (jb == c);
            f32x16 S;
#pragma unroll
            for (int r = 0; r < 16; ++r) S[r] = 0.f;
#pragma unroll
            for (int s = 0; s < 4; ++s) S = MFMA32(cur.k[s], qf[s], S);
            asm volatile("" :: "v"(cur.k[0]), "v"(cur.k[1]), "v"(cur.k[2]), "v"(cur.k[3]));
            const int dist0 = tq - tok - 8 * hi;
            const bool lanesel = own || ((sel >> jb) & 1u);
            float x[16];
            if (jb + 1 < c) {
#pragma unroll
                for (int r = 0; r < 16; ++r) x[r] = lanesel ? (S[r] * c2 + bfar) : -INFINITY;
            } else {
#pragma unroll
                for (int r = 0; r < 16; ++r) {
                    const int dist = dist0 - ((r & 7) + 16 * (r >> 3));
                    const int di = dist < 0 ? 0 : (dist > 127 ? 127 : dist);
                    const float v = S[r] * c2 + lut[di];
                    const bool valid = own ? (dist >= 0) : lanesel;
                    x[r] = valid ? v : -INFINITY;
                }
            }
            float mx = x[0];
#pragma unroll
            for (int r = 1; r < 16; ++r) mx = fmaxf(mx, x[r]);
            mx = fmaxf(mx, __shfl_xor(mx, 32));
            const float m_new = fmaxf(m_run, mx);
            const float alpha = __builtin_amdgcn_exp2f(m_run - m_new);
            float p[16]; float ls = 0.f;
#pragma unroll
            for (int r = 0; r < 16; ++r) { p[r] = __builtin_amdgcn_exp2f(x[r] - m_new); ls += p[r]; }
            l_run = l_run * alpha + ls; m_run = m_new;
#pragma unroll
            for (int r = 0; r < 16; ++r) { o0[r] *= alpha; o1[r] *= alpha; }
            const bf16x8 pb0 = pack8f(p), pb1 = pack8f(p + 8);
            o0 = MFMA32(cur.v[0][0], pb0, o0); o0 = MFMA32(cur.v[0][1], pb1, o0);
            o1 = MFMA32(cur.v[1][0], pb0, o1); o1 = MFMA32(cur.v[1][1], pb1, o1);
        }
        if (!has_next) break;
        if (in_own && tokn < tok) in_own = false;
        if (in_own && !(tok < c * 256 + sub * 32)) in_own = false;
        cur = nxt; tok = tokn;
    }
    const float l = l_run + __shfl_xor(l_run, 32);
    store_o(O + qrow * 1024 + 512 + h * 64 + 8 * hi, o0, o1, 1.f / l);
}

__device__ __forceinline__ void sb_wave(int b, int h, int qblk, int sub, const bf16_t* QK, const bf16_t* VT, bf16_t* O, int lane) {
    const int ql = lane & 31, hi = lane >> 5;
    const int tq = qblk * 256 + sub * 32 + ql;
    const size_t qrow = (size_t)b * SEQ + tq;
    bf16x8 qf[4];
    { const bf16_t* qp = QK + qrow * 2048 + h * 64 + 8 * hi;
#pragma unroll
      for (int s = 0; s < 4; ++s) qf[s] = *(const bf16x8*)(qp + 16 * s); }
    const bf16_t* kbase = QK + (size_t)b * SEQ * 2048 + 512 + h * 64 + 8 * hi + (size_t)swap23(ql) * 2048;
    const bf16_t* vbase = VT + ((size_t)(b * 8 + h) * 64 + swap23(ql)) * 2048 + 8 * hi;
    f32x16 o0, o1;
#pragma unroll
    for (int r = 0; r < 16; ++r) { o0[r] = 0.f; o1[r] = 0.f; }
    float carry = 0.f;
    const int tdiag = qblk * 256 + sub * 32;
    int tok = tdiag;
    Frag cur, nxt;
    load_tile(cur, kbase + (size_t)tok * 2048, vbase + tok);
    for (;;) {
        const bool has_next = tok > 0;
        if (has_next) load_tile(nxt, kbase + (size_t)(tok - 32) * 2048, vbase + (tok - 32));
        {
            f32x16 S;
#pragma unroll
            for (int r = 0; r < 16; ++r) S[r] = 0.f;
#pragma unroll
            for (int s = 0; s < 4; ++s) S = MFMA32(cur.k[s], qf[s], S);
            asm volatile("" :: "v"(cur.k[0]), "v"(cur.k[1]), "v"(cur.k[2]), "v"(cur.k[3]));
            const bool diag = (tok == tdiag);
            float lf[16], zl[16];
            float G0 = 0.f, G1 = 0.f;
#pragma unroll
            for (int r = 0; r < 16; ++r) {
                const int kl = (r & 7) + 8 * hi + 16 * (r >> 3);
                const float z = S[r] * 0.125f;
                const float e = __expf(-fabsf(z));
                float f = -(fmaxf(z, 0.f) + __logf(1.f + e));
                const bool causal = !diag || (kl < ql);
                zl[r] = causal ? (z + f) : -INFINITY;
                f = causal ? f : 0.f; lf[r] = f;
                if (r < 8) G0 += f; else G1 += f;
            }
            const float P0 = __shfl_xor(G0, 32), P1 = __shfl_xor(G1, 32);
            const float a0 = hi ? (P1 + G1) : ((P0 + G1) + P1), a1 = hi ? 0.f : P1;
            float w[16];
            float run = carry + a1;
#pragma unroll
            for (int e = 7; e >= 0; --e) { w[8 + e] = __expf(zl[8 + e] + run); run += lf[8 + e]; }
            run = carry + a0;
#pragma unroll
            for (int e = 7; e >= 0; --e) { w[e] = __expf(zl[e] + run); run += lf[e]; }
            carry += (G0 + G1) + (P0 + P1);
            const bf16x8 pb0 = pack8f(w), pb1 = pack8f(w + 8);
            o0 = MFMA32(cur.v[0][0], pb0, o0); o0 = MFMA32(cur.v[0][1], pb1, o0);
            o1 = MFMA32(cur.v[1][0], pb0, o1); o1 = MFMA32(cur.v[1][1], pb1, o1);
        }
        if (!has_next) break;
        if (__ballot(carry > -104.f) == 0ull) break;
        cur = nxt; tok -= 32;
    }
    store_o(O + qrow * 1024 + h * 64 + 8 * hi, o0, o1, 1.f);
}
}

namespace att2 {
using att::bf16x8; using att::f32x16; using att::Frag; using att::swap23; using att::pack8f; using att::bf2f; using att::store_o;
constexpr int BUF_BYTES = 65536;
struct Stage { u32x4 k[4]; u32x4 v[4]; };
__device__ __forceinline__ void blk_load(Stage& st, const bf16_t* kg, const bf16_t* vg, int t) {
#pragma unroll
    for (int i = 0; i < 4; ++i) { const int p = t + 512 * i; st.k[i] = *(const u32x4*)(kg + (size_t)(p >> 3) * 2048 + (p & 7) * 8); }
#pragma unroll
    for (int i = 0; i < 4; ++i) { const int p = t + 512 * i; st.v[i] = *(const u32x4*)(vg + (size_t)(p >> 5) * 2048 + (p & 31) * 8); }
}
__device__ __forceinline__ void blk_store(const Stage& st, LAS unsigned char* buf, int t) {
#pragma unroll
    for (int i = 0; i < 4; ++i) { const int p = t + 512 * i, r = p >> 3, c = p & 7; *(LAS u32x4*)(buf + r * 128 + ((c ^ ((r >> 1) & 7)) << 4)) = st.k[i]; }
#pragma unroll
    for (int i = 0; i < 4; ++i) { const int p = t + 512 * i, d = p >> 5, c = p & 31; *(LAS u32x4*)(buf + 32768 + d * 512 + ((c ^ (d & 15)) << 4)) = st.v[i]; }
}
__device__ __forceinline__ void tile_frags(Frag& f, const LAS unsigned char* buf, int kt, int sq, int hi) {
    const LAS unsigned char* kp = buf + (kt * 32 + sq) * 128; const int kx = (sq >> 1) & 7;
#pragma unroll
    for (int s = 0; s < 4; ++s) f.k[s] = *(const LAS bf16x8*)(kp + (((2 * s + hi) ^ kx) << 4));
    const int vx = sq & 15;
#pragma unroll
    for (int dt = 0; dt < 2; ++dt)
#pragma unroll
        for (int g = 0; g < 2; ++g) f.v[dt][g] = *(const LAS bf16x8*)(buf + 32768 + (32 * dt + sq) * 512 + (((4 * kt + 2 * g + hi) ^ vx) << 4));
}
__device__ __forceinline__ void wg_barrier() { __syncthreads(); }

struct MobaSt { f32x16 o0, o1; float m_run, l_run; };
__device__ __forceinline__ void moba_tile(MobaSt& st, const Frag& cur, const bf16x8 (&qf)[4], int tok, int c, int tq, int hi, unsigned sel, const LAS float* lut, float bfar) {
    const float c2 = 0.125f * LOG2E;
    const int jb = tok >> 8; const bool own = (jb == c);
    f32x16 S;
#pragma unroll
    for (int r = 0; r < 16; ++r) S[r] = 0.f;
    __builtin_amdgcn_s_setprio(1);
#pragma unroll
    for (int s = 0; s < 4; ++s) S = MFMA32(cur.k[s], qf[s], S);
    __builtin_amdgcn_s_setprio(0);
    asm volatile("" :: "v"(cur.k[0]), "v"(cur.k[1]), "v"(cur.k[2]), "v"(cur.k[3]));
    float p[16]; float ls = 0.f; float m_new;
    if ((tq & ~31) - tok >= 144) {
        const bool lanesel = own || (((sel >> jb) & 1u) != 0u);
        float ms = S[0];
#pragma unroll
        for (int r = 1; r < 16; ++r) ms = fmaxf(ms, S[r]);
        float mx = lanesel ? (ms * c2 + bfar) : -INFINITY;
        mx = fmaxf(mx, __shfl_xor(mx, 32));
        m_new = fmaxf(st.m_run, mx);
        const float nb = lanesel ? (bfar - m_new) : -INFINITY;
#pragma unroll
        for (int r = 0; r < 16; ++r) { p[r] = __builtin_amdgcn_exp2f(S[r] * c2 + nb); ls += p[r]; }
    } else {
        const int dist0 = tq - tok - 8 * hi;
        const bool lanesel = own || ((sel >> jb) & 1u);
        float x[16];
#pragma unroll
        for (int r = 0; r < 16; ++r) {
            const int dist = dist0 - ((r & 7) + 16 * (r >> 3));
            const int di = dist < 0 ? 0 : (dist > 127 ? 127 : dist);
            const float v = S[r] * c2 + lut[di];
            const bool valid = own ? (dist >= 0) : lanesel;
            x[r] = valid ? v : -INFINITY;
        }
        float mx = x[0];
#pragma unroll
        for (int r = 1; r < 16; ++r) mx = fmaxf(mx, x[r]);
        mx = fmaxf(mx, __shfl_xor(mx, 32));
        m_new = fmaxf(st.m_run, mx);
#pragma unroll
        for (int r = 0; r < 16; ++r) { p[r] = __builtin_amdgcn_exp2f(x[r] - m_new); ls += p[r]; }
    }
    const float alpha = __builtin_amdgcn_exp2f(st.m_run - m_new);
    st.l_run = st.l_run * alpha + ls;
    if (__ballot(m_new > st.m_run) != 0ull) {
#pragma unroll
        for (int r = 0; r < 16; ++r) { st.o0[r] *= alpha; st.o1[r] *= alpha; }
    }
    st.m_run = m_new;
    const bf16x8 pb0 = pack8f(p), pb1 = pack8f(p + 8);
    __builtin_amdgcn_s_setprio(1);
    st.o0 = MFMA32(cur.v[0][0], pb0, st.o0); st.o1 = MFMA32(cur.v[1][0], pb0, st.o1);
    st.o0 = MFMA32(cur.v[0][1], pb1, st.o0); st.o1 = MFMA32(cur.v[1][1], pb1, st.o1);
    __builtin_amdgcn_s_setprio(0);
}

__device__ __forceinline__ void moba_unit(int b, int h, int c, int sub, const bf16_t* QK, const bf16_t* VT, const float* kpart, bf16_t* O,
                                          const LAS float* lut, LAS float* kb, LAS unsigned* ctl, LAS unsigned char* bufs, int wave, int lane, int t,
                                          Stage& stg, const bf16_t* nkg, const bf16_t* nvg) {
    const int ql = lane & 31, hi = lane >> 5, sq = swap23(ql);
    const int tq = c * 256 + sub * 32 + ql;
    const size_t qrow = (size_t)b * SEQ + tq;
    const bf16_t* kg0 = QK + (size_t)b * SEQ * 2048 + 1536 + h * 64;
    const bf16_t* vg0 = VT + ((size_t)((32 + b) * 8 + h) * 64) * 2048;
    { float ka[7], kc[7];
#pragma unroll
      for (int j = 0; j < 7; ++j) { const float* kp = kpart + (size_t)((b * 8 + (j < c ? j : 0)) * 2) * 512 + h * 64 + lane; ka[j] = kp[0]; kc[j] = kp[512]; }
#pragma unroll
      for (int j = 0; j < 7; ++j) if (j < c) kb[j * 64 + lane] = (ka[j] + kc[j]) * (1.f / 256.f); }
    asm volatile("s_waitcnt lgkmcnt(0)" ::: "memory");
    bf16x8 qf[4];
    { const bf16_t* qp = QK + qrow * 2048 + 1024 + h * 64 + 8 * hi;
#pragma unroll
      for (int s = 0; s < 4; ++s) qf[s] = *(const bf16x8*)(qp + 16 * s); }
    unsigned sel;
    if (c <= 3) sel = (1u << c) - 1u;
    else {
        float g[7];
#pragma unroll
        for (int j = 0; j < 7; ++j) {
            float a = -INFINITY;
            if (j < c) {
                a = 0.f;
#pragma unroll
                for (int s = 0; s < 4; ++s)
#pragma unroll
                    for (int e = 0; e < 8; ++e) a += bf2f(qf[s][e]) * kb[j * 64 + 16 * s + 8 * hi + e];
                a += __shfl_xor(a, 32);
            }
            g[j] = a;
        }
        sel = 0u;
#pragma unroll
        for (int k = 0; k < 3; ++k) {
            float best = -INFINITY; int bi = 0;
#pragma unroll
            for (int j = 0; j < 7; ++j) { const bool tt = !((sel >> j) & 1u) && g[j] > best; best = tt ? g[j] : best; bi = tt ? j : bi; }
            sel |= 1u << bi;
        }
    }
    unsigned remw = 0u;
    for (int j = 0; j < c; ++j) if (__ballot((sel >> j) & 1u) != 0ull) remw |= 1u << j;
    remw = __builtin_amdgcn_readfirstlane(remw);
    if (lane == 0) ctl[wave] = remw;
    blk_store(stg, bufs, t);
    __builtin_amdgcn_s_waitcnt(0x0F70);
    wg_barrier();
    unsigned rem = 0u;
#pragma unroll
    for (int w = 0; w < 8; ++w) rem |= ctl[w];
    rem = __builtin_amdgcn_readfirstlane(rem);

    MobaSt st;
#pragma unroll
    for (int r = 0; r < 16; ++r) { st.o0[r] = 0.f; st.o1[r] = 0.f; }
    st.m_run = -INFINITY; st.l_run = 0.f;
    const float bfar = lut[127];
    int jb = c, i = 0;
    for (;;) {
        int jn = -1; if (rem) { jn = __builtin_ctz(rem); rem &= rem - 1u; }
        if (jn >= 0) blk_load(stg, kg0 + (size_t)jn * 256 * 2048, vg0 + jn * 256, t);
        const LAS unsigned char* buf = bufs + (i & 1) * BUF_BYTES;
        if (jb == c || ((remw >> jb) & 1u)) {
            const int nkt = (jb == c) ? sub + 1 : 8;
            for (int kt = 0; kt < nkt; ++kt) { Frag f; tile_frags(f, buf, kt, sq, hi); moba_tile(st, f, qf, jb * 256 + kt * 32, c, tq, hi, sel, lut, bfar); }
        }
        if (jn < 0) break;
        blk_store(stg, bufs + ((i + 1) & 1) * BUF_BYTES, t);
        wg_barrier();
        jb = jn; ++i;
    }
    if (nkg) blk_load(stg, nkg, nvg, t);
    const float l = st.l_run + __shfl_xor(st.l_run, 32);
    store_o(O + qrow * 1024 + 512 + h * 64 + 8 * hi, st.o0, st.o1, 1.f / l);
    wg_barrier();
}

struct SbSt { f32x16 o0, o1; float carry; };
template <bool DIAG> __device__ __forceinline__ void sb_tile(SbSt& st, const Frag& cur, const bf16x8 (&qf)[4], int ql, int hi) {
    f32x16 S;
#pragma unroll
    for (int r = 0; r < 16; ++r) S[r] = 0.f;
    __builtin_amdgcn_s_setprio(1);
#pragma unroll
    for (int s = 0; s < 4; ++s) S = MFMA32(cur.k[s], qf[s], S);
    __builtin_amdgcn_s_setprio(0);
    asm volatile("" :: "v"(cur.k[0]), "v"(cur.k[1]), "v"(cur.k[2]), "v"(cur.k[3]));
    float bt[16], om[16];
    float G0 = 1.f, G1 = 1.f;
#pragma unroll
    for (int r = 0; r < 16; ++r) {
        const float e = __builtin_amdgcn_exp2f(-fabsf(S[r]) * (0.125f * LOG2E));
        const float rc = __builtin_amdgcn_rcpf(1.f + e), er = e * rc;
        float beta = S[r] > 0.f ? rc : er, omb = S[r] > 0.f ? er : rc;
        if (DIAG) { const int kl = (r & 7) + 8 * hi + 16 * (r >> 3); const bool causal = kl < ql; beta = causal ? beta : 0.f; omb = causal ? omb : 1.f; }
        bt[r] = beta; om[r] = omb;
        if (r < 8) G0 *= omb; else G1 *= omb;
    }
    const float P0 = __shfl_xor(G0, 32), P1 = __shfl_xor(G1, 32);
    const float a0 = hi ? (P1 * G1) : ((P0 * G1) * P1), a1 = hi ? 1.f : P1;
    float w[16];
    float run = st.carry * a1;
#pragma unroll
    for (int e = 7; e >= 0; --e) { w[8 + e] = bt[8 + e] * run; run *= om[8 + e]; }
    run = st.carry * a0;
#pragma unroll
    for (int e = 7; e >= 0; --e) { w[e] = bt[e] * run; run *= om[e]; }
    st.carry *= (G0 * G1) * (P0 * P1);
    const bf16x8 pb0 = pack8f(w), pb1 = pack8f(w + 8);
    __builtin_amdgcn_s_setprio(1);
    st.o0 = MFMA32(cur.v[0][0], pb0, st.o0); st.o1 = MFMA32(cur.v[1][0], pb0, st.o1);
    st.o0 = MFMA32(cur.v[0][1], pb1, st.o0); st.o1 = MFMA32(cur.v[1][1], pb1, st.o1);
    __builtin_amdgcn_s_setprio(0);
}
__device__ __forceinline__ bool sb_dead(const SbSt& st) { return __ballot(st.carry >= 1.17549435e-38f) == 0ull; }

__device__ __forceinline__ void sb_unit(int b, int h, int qblk, int sub, const bf16_t* QK, const bf16_t* VT, bf16_t* O,
                                        LAS unsigned* ctl, LAS unsigned char* bufs, int wave, int lane, int t, Stage& stg, const bf16_t* nkg, const bf16_t* nvg) {
    const int ql = lane & 31, hi = lane >> 5, sq = swap23(ql);
    const int tq = qblk * 256 + sub * 32 + ql;
    const size_t qrow = (size_t)b * SEQ + tq;
    const bf16_t* kg0 = QK + (size_t)b * SEQ * 2048 + 512 + h * 64;
    const bf16_t* vg0 = VT + ((size_t)(b * 8 + h) * 64) * 2048;
    Stage stg2;
    if (qblk > 0) blk_load(stg2, kg0 + (size_t)(qblk - 1) * 256 * 2048, vg0 + (qblk - 1) * 256, t);
    bf16x8 qf[4];
    { const bf16_t* qp = QK + qrow * 2048 + h * 64 + 8 * hi;
#pragma unroll
      for (int s = 0; s < 4; ++s) qf[s] = *(const bf16x8*)(qp + 16 * s); }
    if (t < 8) ctl[8 + t] = 0u;
    blk_store(stg, bufs, t);
    if (qblk > 0) blk_store(stg2, bufs + BUF_BYTES, t);
    __builtin_amdgcn_s_waitcnt(0x0F70);
    wg_barrier();
    if (nkg) blk_load(stg, nkg, nvg, t);
    SbSt st;
#pragma unroll
    for (int r = 0; r < 16; ++r) { st.o0[r] = 0.f; st.o1[r] = 0.f; }
    st.carry = 1.f;
    bool done = false;
    { Frag f; tile_frags(f, bufs, sub, sq, hi); sb_tile<true>(st, f, qf, ql, hi); done = sb_dead(st); }
    for (int kt = sub - 1; kt >= 0 && !done; --kt) { Frag f; tile_frags(f, bufs, kt, sq, hi); sb_tile<false>(st, f, qf, ql, hi); done = sb_dead(st); }
    if (qblk > 0)
        for (int kt = 7; kt >= 0 && !done; --kt) { Frag f; tile_frags(f, bufs + BUF_BYTES, kt, sq, hi); sb_tile<false>(st, f, qf, ql, hi); done = sb_dead(st); }
    int jb = qblk - 2, i = 0;
    for (;;) {
        if (!done && jb >= 0 && lane == 0) ctl[8 + i] = 1u;
        wg_barrier();
        if (jb < 0 || ctl[8 + i] == 0u) break;
        blk_load(stg2, kg0 + (size_t)jb * 256 * 2048, vg0 + jb * 256, t);
        blk_store(stg2, bufs + (i & 1) * BUF_BYTES, t);
        wg_barrier();
        for (int kt = 7; kt >= 0 && !done; --kt) { Frag f; tile_frags(f, bufs + (i & 1) * BUF_BYTES, kt, sq, hi); sb_tile<false>(st, f, qf, ql, hi); done = sb_dead(st); }
        --jb; ++i;
    }
    store_o(O + qrow * 1024 + h * 64 + 8 * hi, st.o0, st.o1, 1.f);
    wg_barrier();
}
}

__device__ __forceinline__ float wave_sum(float v) {
#pragma unroll
    for (int o = 1; o < 64; o <<= 1) v += __shfl_xor(v, o);
    return v;
}
__device__ __forceinline__ void p0_transpose_item(const float* W, int K, int N, const float* gk, bf16_t* WT, int k0, int n0, int dst_row0, LAS float* scr, int lane) {
    {
        f32x4 w4[8]; const int c4 = (lane & 7) * 4, kr = lane >> 3;
#pragma unroll
        for (int i = 0; i < 8; ++i) w4[i] = *(const f32x4*)(W + (size_t)(k0 + 8 * i + kr) * N + n0 + c4);
#pragma unroll
        for (int i = 0; i < 8; ++i) { const int kk = 8 * i + kr; f32x4 w = w4[i]; if (gk) w = w * gk[k0 + kk];
            LAS float* d = scr + kk * 33 + c4; d[0] = w[0]; d[1] = w[1]; d[2] = w[2]; d[3] = w[3]; }
    }
    asm volatile("s_waitcnt lgkmcnt(0)" ::: "memory");
    const int c = lane & 7;
#pragma unroll
    for (int j = 0; j < 4; ++j) { const int n = (lane >> 3) + 8 * j; const LAS float* s = scr + (8 * c) * 33 + n;
        u32x4 o; o.x = cvt_pk_bf16(s[0 * 33], s[1 * 33]); o.y = cvt_pk_bf16(s[2 * 33], s[3 * 33]); o.z = cvt_pk_bf16(s[4 * 33], s[5 * 33]); o.w = cvt_pk_bf16(s[6 * 33], s[7 * 33]);
        *(u32x4*)(WT + (size_t)(dst_row0 + n) * K + k0 + 8 * c) = o; }
    asm volatile("s_waitcnt lgkmcnt(0)" ::: "memory");
}

struct Args { const float* in[18]; float* out; unsigned char* ws; };

#define XB_TMO      128
#define XB_XCNT(j)  (256  + 64 * (j))
#define XB_XSUB(j)  (1280 + 64 * (j))
#define XB_XGEN(j)  (2304 + 64 * (j))
#define XB_TOP      3328
#define XB_TOPGEN   3392
#define XCD_BAR_WORDS 3456
#define XB_SPIN_CAP (1u << 18)

__device__ __forceinline__ unsigned xb_ld(unsigned* p)              { return __hip_atomic_load(p, __ATOMIC_RELAXED, __HIP_MEMORY_SCOPE_AGENT); }
__device__ __forceinline__ unsigned xb_add(unsigned* p, unsigned v) { return __hip_atomic_fetch_add(p, v, __ATOMIC_RELAXED, __HIP_MEMORY_SCOPE_AGENT); }
__device__ __forceinline__ unsigned xb_xcc_id() { return (unsigned)__builtin_amdgcn_s_getreg((3 << 11) | 20) & 0xFu; }
#define XB_SPIN(cond, bar) do { unsigned _sp = 0; while (cond) { __builtin_amdgcn_s_sleep(1); \
    if ((++_sp & 255u) == 0u) { if (xb_ld(&(bar)[XB_TMO])) break; if (_sp > XB_SPIN_CAP) { atomicAdd(&(bar)[XB_TMO], 1u); break; } } } } while (0)

struct XcdBarrier {
    unsigned* bar; unsigned x;
    volatile LAS unsigned* st;
};

__device__ __forceinline__ XcdBarrier xcd_barrier_post(unsigned* bar, volatile LAS unsigned* st) {
    XcdBarrier b; b.bar = bar; b.x = xb_xcc_id(); b.st = st;
    if (threadIdx.x == 0) (void)xb_add(&bar[XB_XCNT(b.x)], 1u);
    return b;
}
__device__ __forceinline__ void xcd_barrier_complete(unsigned* bar, unsigned x, unsigned& nloc, unsigned& nx) {
    const unsigned G = gridDim.x * gridDim.y * gridDim.z;
    unsigned sum, cnt, mine, sp = 0u;
    for (;;) {
        sum = 0u; cnt = 0u; mine = 0u;
#pragma unroll
        for (unsigned j = 0; j < 16; ++j) { const unsigned c = xb_ld(&bar[XB_XCNT(j)]); sum += c; cnt += (c > 0u) ? 1u : 0u; mine = (j == x) ? c : mine; }
        if (sum == G) break;
        __builtin_amdgcn_s_sleep(1);
        if ((++sp & 255u) == 0u) { if (xb_ld(&bar[XB_TMO])) break; if (sp > XB_SPIN_CAP) { atomicAdd(&bar[XB_TMO], 1u); break; } }
    }
    nloc = mine > 0u ? mine : 1u; nx = cnt > 0u ? cnt : 1u;
}

__device__ __forceinline__ void xcd_barrier(const XcdBarrier& b) {
    asm volatile("s_waitcnt vmcnt(0)" ::: "memory");
    __syncthreads();
    if (threadIdx.x == 0) {
        unsigned* bar = b.bar;
        __builtin_amdgcn_s_waitcnt(0);
        unsigned nloc = b.st[0], nx = b.st[1];
        if (nloc == 0u) { xcd_barrier_complete(bar, b.x, nloc, nx); b.st[0] = nloc; b.st[1] = nx; }
        const unsigned old = xb_add(&bar[XB_XSUB(b.x)], 1u);
        const unsigned gen = old / nloc;
        if (old + 1u == (gen + 1u) * nloc) {
            __builtin_amdgcn_fence(__ATOMIC_RELEASE, "agent");
            asm volatile("s_waitcnt vmcnt(0)" ::: "memory");
            const unsigned og = xb_add(&bar[XB_TOP], 1u);
            const unsigned tg = og / nx;
            if (og + 1u == (tg + 1u) * nx) xb_add(&bar[XB_TOPGEN], 1u);
            else XB_SPIN(xb_ld(&bar[XB_TOPGEN]) == tg, bar);
            __builtin_amdgcn_fence(__ATOMIC_ACQUIRE, "agent");
            xb_add(&bar[XB_XGEN(b.x)], 1u);
            asm volatile("s_waitcnt vmcnt(0)" ::: "memory");
        } else {
            XB_SPIN(xb_ld(&bar[XB_XGEN(b.x)]) == gen, bar);
            __builtin_amdgcn_fence(__ATOMIC_ACQUIRE, "agent");
            asm volatile("s_waitcnt vmcnt(0)" ::: "memory");
        }
    }
    __syncthreads();
}

__device__ __forceinline__ void chain_fence() { __builtin_amdgcn_fence(__ATOMIC_ACQUIRE, "workgroup"); }
__device__ __forceinline__ void compute_rs(const float* ssq, int pm, LAS float* rs, int tid_) {
    int tid = tid_; asm volatile("" : "+v"(tid));
    if (tid < 256) { const f32x4* p = (const f32x4*)(ssq + (size_t)(pm * 256 + tid) * 16); const f32x4 a = p[0], b = p[1], c = p[2], d = p[3];
        const float s = (((a[0] + a[1]) + (a[2] + a[3])) + ((b[0] + b[1]) + (b[2] + b[3]))) + (((c[0] + c[1]) + (c[2] + c[3])) + ((d[0] + d[1]) + (d[2] + d[3])));
        rs[tid] = rsqrtf(s * (1.f / DM) + EPS); }
    __syncthreads();
}

__device__ __forceinline__ int lane_id_() { int l; asm volatile("v_mbcnt_lo_u32_b32 %0, -1, 0\n\tv_mbcnt_hi_u32_b32 %0, -1, %0" : "=v"(l)); return l; }
template <int PLO, int PHI>
__global__ void __launch_bounds__(512, 2) fwd_megakernel(Args args) {
    extern __shared__ __attribute__((aligned(16))) unsigned char lds_raw[];
    LAS unsigned char* lds = (LAS unsigned char*)lds_raw;
    cg::grid_group grid = cg::this_grid();
    const int wave = __builtin_amdgcn_readfirstlane((int)threadIdx.x >> 6);
#define lane (lane_id_())
#define tid (wave * 64 + lane)
    const int G = gridDim.x, bx = blockIdx.x;
    unsigned char* ws = args.ws;
    const float* x = args.in[0]; float* out = args.out;
    float* rstd0 = (float*)(ws + WS_RSTD0); float* kpart = (float*)(ws + WS_KPART);
    bf16_t* W1t = (bf16_t*)(ws + WS_W1T); bf16_t* Wvt = (bf16_t*)(ws + WS_WVT); bf16_t* W3t = (bf16_t*)(ws + WS_W3T); bf16_t* Wot = (bf16_t*)(ws + WS_WOT); bf16_t* Wgut = (bf16_t*)(ws + WS_WGUT);
    bf16_t* Wdt = (bf16_t*)(ws + WS_WDT); bf16_t* Wpgt = (bf16_t*)(ws + WS_WPGT); bf16_t* Wppt = (bf16_t*)(ws + WS_WPPT);
    float* ssq1 = (float*)(ws + WS_SSQ1); float* ssq2 = (float*)(ws + WS_SSQ2); float* ssq3 = (float*)(ws + WS_SSQ3);
    bf16_t* PB = (bf16_t*)(ws + WS_PB); bf16_t* XB = (bf16_t*)(ws + WS_XB); bf16_t* QK = (bf16_t*)(ws + WS_QK); bf16_t* VT = (bf16_t*)(ws + WS_VT);
    bf16_t* HB = (bf16_t*)(ws + WS_H); bf16_t* Gt = (bf16_t*)(ws + WS_GT); bf16_t* PP = (bf16_t*)out; bf16_t* A2 = (bf16_t*)(ws + WS_A2);
    bf16_t* MIX = XB; bf16_t* XB2 = XB; bf16_t* XB1 = A2; bf16_t* XB3 = A2;
    LAS float* rs = (LAS float*)(lds + RS_OFF);
    volatile LAS unsigned* xb_st = (volatile LAS unsigned*)(lds + 151680);
    if (threadIdx.x < 2) xb_st[threadIdx.x] = 0u;
    __syncthreads();
    XcdBarrier xbar = xcd_barrier_post((unsigned*)(ws + WS_RSTD0 + 512 * 1024), xb_st);
    if (args.ws == nullptr) grid.sync();
#if PROBE_T
    const unsigned long long t_start = __builtin_amdgcn_s_memrealtime(); float t_probe = 0.f;
#define STAMP(k) do { if (PROBE_T == (k)) t_probe = (float)(__builtin_amdgcn_s_memrealtime() - t_start) * 0.01f; } while (0)
#else
#define STAMP(k) do {} while (0)
#endif

#define PH_IN(k) (PLO <= (k) && (k) < PHI)
    if constexpr (PH_IN(0)) {
        LAS float* scr = (LAS float*)(lds + wave * 16384);
        const int gw = bx * 8 + wave, NGW = G * 8;
        constexpr int I1 = 16 * 96, I2 = 16 * 64, I3 = 8 * 32, I5 = 16 * 32, I6 = 16 * 88, I8 = 44 * 32, I10 = 4 * 32;
        constexpr int NITEMS = I1 + I2 + 2 * I3 + I5 + 2 * I6 + I8 + I5 + I10;
        for (int it = gw; it < NITEMS; it += NGW) {
            int r = it;
            if (r < I1) { const int kb = r / 96, nb = r % 96, n0 = 32 * nb, grp = n0 >> 9, o = n0 & 511;
                bf16_t* dW = (grp == 2 || grp == 5) ? Wvt : W1t; const int dr = (grp == 2 ? 0 : grp == 5 ? 512 : grp == 0 ? 0 : grp == 1 ? 512 : grp == 3 ? 1024 : 1536) + o;
                p0_transpose_item(args.in[3], 1024, 3072, args.in[2], dW, 64 * kb, n0, dr, scr, lane); continue; } r -= I1;
            if (r < I2) { const int kb = r / 64, nb = r % 64; p0_transpose_item(args.in[4], 1024, 2048, args.in[2], W1t, 64 * kb, 32 * nb, 2048 + 32 * nb, scr, lane); continue; } r -= I2;
            if (r < I3) { const int kb = r / 32, nb = r % 32; p0_transpose_item(args.in[6], 512, 1024, nullptr, W3t, 64 * kb, 32 * nb, 32 * nb, scr, lane); continue; } r -= I3;
            if (r < I3) { const int kb = r / 32, nb = r % 32; p0_transpose_item(args.in[7], 512, 1024, nullptr, W3t, 64 * kb, 32 * nb, 1024 + 32 * nb, scr, lane); continue; } r -= I3;
            if (r < I5) { const int kb = r / 32, nb = r % 32; p0_transpose_item(args.in[8], 1024, 1024, nullptr, Wot, 64 * kb, 32 * nb, 32 * nb, scr, lane); continue; } r -= I5;
            if (r < I6) { const int kb = r / 88, nb = r % 88, n0 = 32 * nb; p0_transpose_item(args.in[11], 1024, FFH, args.in[10], Wgut, 64 * kb, n0, 256 * (n0 >> 7) + (n0 & 127), scr, lane); continue; } r -= I6;
            if (r < I6) { const int kb = r / 88, nb = r % 88, n0 = 32 * nb; p0_transpose_item(args.in[12], 1024, FFH, args.in[10], Wgut, 64 * kb, n0, 256 * (n0 >> 7) + 128 + (n0 & 127), scr, lane); continue; } r -= I6;
            if (r < I8) { const int kb = r / 32, nb = r % 32; p0_transpose_item(args.in[13], FFH, 1024, nullptr, Wdt, 64 * kb, 32 * nb, 32 * nb, scr, lane); continue; } r -= I8;
            if (r < I5) { const int kb = r / 32, nb = r % 32; p0_transpose_item(args.in[15], 1024, 1024, args.in[14], Wpgt, 64 * kb, 32 * nb, 32 * nb, scr, lane); continue; } r -= I5;
            { const int kb = r / 32, nb = r % 32; p0_transpose_item(args.in[16], PLE, 1024, nullptr, Wppt, 64 * kb, 32 * nb, 32 * nb, scr, lane); }
        }
        for (int m0 = gw * 32; m0 < MTOK; m0 += NGW * 32)
        for (int m = m0; m < m0 + 32; ++m) {
            const f32x4* xr = (const f32x4*)(x + (size_t)m * DM) + lane; f32x4 v[4]; float s = 0.f;
#pragma unroll
            for (int j = 0; j < 4; ++j) { v[j] = xr[64 * j]; s += (v[j][0] * v[j][0] + v[j][1] * v[j][1]) + (v[j][2] * v[j][2] + v[j][3] * v[j][3]); }
            s = wave_sum(s);
            if (lane == 0) rstd0[m] = rsqrtf(s * (1.f / DM) + EPS);
            u32x2* o8 = (u32x2*)(XB + (size_t)m * DM) + lane;
#pragma unroll
            for (int j = 0; j < 4; ++j) { u32x2 w; w.x = cvt_pk_bf16(v[j][0], v[j][1]); w.y = cvt_pk_bf16(v[j][2], v[j][3]); o8[64 * j] = w; }
        }
        const float* p = args.in[1];
        for (size_t i = (size_t)bx * 512 + tid; i < (size_t)MTOK * PLE / 8; i += (size_t)G * 512) {
            const f32x4 a = *(const f32x4*)(p + i * 8), b = *(const f32x4*)(p + i * 8 + 4);
            *(u32x4*)(PB + i * 8) = pack8(a, b);
        }
    }
    if constexpr (PH_IN(0) && PH_IN(1)) {
    xcd_barrier(xbar);
    }
    STAMP(1);

    if constexpr (PH_IN(1)) if (bx < NP) for (int rep_ = 0; rep_ < REP_P1; ++rep_) { const int pm = bx;
        { pg8::Gemm g{XB, W1t, 1024, 1024}; XcdOrder S; S.init(NP, 16, G, bx, 4);
          Epi1 E{rstd0, args.in[5], QK, Gt, kpart};
          pg8::gemm_phase<Epi1, XcdOrder, true, true>(lds, g, S, E, wave); }
        { pg8::Gemm g{Wvt, XB, 1024, 1024}; XcdOrder S; S.init(4, NP, G, bx);
          EpiVT E{rstd0, VT};
          pg8::gemm_phase<EpiVT, XcdOrder, true, true>(lds, g, S, E, wave); }
        { pg8::Gemm g{PB, Wppt, PLE, PLE}; XcdOrder S; S.init(NP, 4, G, bx);
          EpiPP E{PP};
          pg8::gemm_phase<EpiPP, XcdOrder, true, true>(lds, g, S, E, wave); }
    }
    if constexpr (PH_IN(1) && PH_IN(2)) {
    xcd_barrier(xbar);
    }
    STAMP(2);

    if constexpr (PH_IN(2)) {
        LAS float* lut = (LAS float*)(lds + 131072);
        LAS float* kb = (LAS float*)(lds + 135168 + wave * 2048);
        LAS unsigned* ctl = (LAS unsigned*)(lds + 151552);
        const float* rel_bias = args.in[9];
        for (int i = tid; i < 1024; i += 512) { const int hh = i >> 7, d = i & 127;
            int bk = d; if (d >= 16) { bk = 16 + (int)(logf((float)d / 16.f) / logf(8.f) * 16.f); bk = bk > 31 ? 31 : bk; }
            lut[i] = rel_bias[bk * 8 + hh] * LOG2E; }
        __syncthreads();
#define UNIT_KG(u) (QK + (size_t)(((u) & 255) >> 3) * SEQ * 2048 + ((u) < 2048 ? 1536 : 512) + (((u) & 255) & 7) * 64 + (size_t)(7 - (((u) & 2047) >> 8)) * 256 * 2048)
#define UNIT_VG(u) (VT + ((size_t)((((u) < 2048 ? 32 : 0) + (((u) & 255) >> 3)) * 8 + (((u) & 255) & 7)) * 64) * 2048 + (7 - (((u) & 2047) >> 8)) * 256)
        att2::Stage stg;
        if (bx < 4096) att2::blk_load(stg, UNIT_KG(bx), UNIT_VG(bx), tid);
        int ui = 0;
        for (int u_ = bx; u_ < 4096 * REP_P2; u_ += G, ++ui) { const int u = u_ & 4095;
            const int sub = (wave + ui) & 7;
            const bool hn = (u_ + G) < 4096 * REP_P2; const int un = (u_ + G) & 4095;
            const bf16_t* nkg = hn ? UNIT_KG(un) : nullptr; const bf16_t* nvg = hn ? UNIT_VG(un) : nullptr;
            if (u < 2048) { const int c = 7 - (u >> 8), bh = u & 255;
                att2::moba_unit(bh >> 3, bh & 7, c, sub, QK, VT, kpart, A2, lut + (bh & 7) * 128, kb, ctl, lds, wave, lane, tid, stg, nkg, nvg);
            } else { const int v = u - 2048, qblk = 7 - (v >> 8), bh = v & 255;
                att2::sb_unit(bh >> 3, bh & 7, qblk, sub, QK, VT, A2, ctl, lds, wave, lane, tid, stg, nkg, nvg);
            }
        }
    }
    if constexpr (PH_IN(2) && PH_IN(3)) {
    xcd_barrier(xbar);
    }
    STAMP(3);

    if constexpr (PH_IN(3)) if (bx < NP) { const int pm = bx;
#define P7A_BLOCK { pg8::Gemm g{PB, Wppt, PLE, PLE}; PanelSched S{pm, 4, 0}; EpiPP E{PP}; pg8::gemm_phase<EpiPP, PanelSched, true, true>(lds, g, S, E, wave); chain_fence(); }
        {
            pg8::Gemm g{A2, W3t, 1024, 512}; PanelSched S{pm, 8, 1}; Epi3 E{Gt, MIX};
            pg8::gemm_phase<Epi3, PanelSched, true, true>(lds, g, S, E, wave); chain_fence(); STAMP(4);
        }
        {
            pg8::Gemm g{MIX, Wot, 1024, 1024}; PanelSched S{pm, 4, 0}; EpiRes<0> E{x, nullptr, XB1, ssq1, nullptr, rs};
            pg8::gemm_phase<EpiRes<0>, PanelSched, true, true>(lds, g, S, E, wave); chain_fence(); STAMP(5);
        }
        compute_rs(ssq1, pm, rs, tid);
        for (int rep_ = 0; rep_ < REP_P5; ++rep_)
        {
            pg8::Gemm g{XB1, Wgut, 1024, 1024}; PanelSched S{pm, 22, 0}; Epi5 E{HB, rs};
            pg8::gemm_phase<Epi5, PanelSched, true, true>(lds, g, S, E, wave); chain_fence(); STAMP(6);
        }
        {
            pg8::Gemm g{HB, Wdt, FFH, FFH}; PanelSched S{pm, 4, 0}; EpiRes<2> E{nullptr, XB1, XB2, ssq2, nullptr, rs};
            pg8::gemm_phase<EpiRes<2>, PanelSched, true, true>(lds, g, S, E, wave); chain_fence(); STAMP(7);
        }
        compute_rs(ssq2, pm, rs, tid);
        {
            pg8::Gemm g{XB2, Wpgt, 1024, 1024}; PanelSched S{pm, 4, 0}; EpiRes<1> E{nullptr, XB2, XB3, ssq3, PP, rs};
            pg8::gemm_phase<EpiRes<1>, PanelSched, true, true>(lds, g, S, E, wave); chain_fence(); STAMP(8);
        }
        compute_rs(ssq3, pm, rs, tid);
        {
            const f32x4* fg = (const f32x4*)args.in[17] + lane;
            for (int r = wave; r < 256; r += 8) {
                const size_t ro = (size_t)(pm * 256 + r) * DM; const u32x2* xr = (const u32x2*)(XB3 + ro) + lane; f32x4* pr = (f32x4*)(out + ro) + lane; const float s = rs[r];
#pragma unroll
                for (int j = 0; j < 4; ++j) { const u32x2 t = xr[64 * j]; const f32x4 v = {bflo(t.x), bfhi(t.x), bflo(t.y), bfhi(t.y)}; pr[64 * j] = v * s * fg[64 * j]; }
            }
        }
        __syncthreads();
#if PROBE_T
        if (bx == 0 && tid == 0) out[0] = t_probe;
#endif
    }
}

extern "C" void kernel_launch(void* const* d_in, const int* in_sizes, int n_in, void* d_out, int out_size, void* d_ws, size_t ws_size, hipStream_t stream) {
    static int grid = 0;
    if (grid == 0) {
        if (n_in != 18 || out_size != MTOK * DM || ws_size < WS_END) { fprintf(stderr, "kernel_launch: unexpected problem shape (n_in %d, out %d, ws %zu)\n", n_in, out_size, ws_size); grid = -1; return; }
        int dev = 0, cus = 0, per_cu = 0;
        hipGetDevice(&dev); hipDeviceGetAttribute(&cus, hipDeviceAttributeMultiprocessorCount, dev);
        if (hipFuncSetAttribute((const void*)fwd_megakernel<0, 4>, hipFuncAttributeMaxDynamicSharedMemorySize, LDS_BYTES) != hipSuccess) fprintf(stderr, "kernel_launch: hipFuncSetAttribute failed\n");
        if (hipOccupancyMaxActiveBlocksPerMultiprocessor(&per_cu, (const void*)fwd_megakernel<0, 4>, 512, LDS_BYTES) != hipSuccess || per_cu < 1) { fprintf(stderr, "kernel_launch: occupancy query says %d\n", per_cu); per_cu = 1; }
        (void)hipGetLastError();
        if (N_LAUNCHES == 1 && cus * per_cu < NP) { fprintf(stderr, "kernel_launch: needs %d co-resident workgroups, device holds %d\n", NP, cus * per_cu); }
        grid = NP;
    }
    if (grid < 0) return;
    if (hipMemsetAsync((char*)d_ws + WS_RSTD0 + 512 * 1024, 0, 16384, stream) != hipSuccess) fprintf(stderr, "kernel_launch: hipMemsetAsync failed\n");
    Args a{};
    for (int i = 0; i < 18; ++i) a.in[i] = (const float*)d_in[i];
    a.out = (float*)d_out; a.ws = (unsigned char*)d_ws;
    hipError_t e = hipSuccess;
#if N_LAUNCHES == 1
    void* kargs[] = {&a};
    e = hipLaunchCooperativeKernel((const void*)fwd_megakernel<0, 4>, dim3(grid), dim3(512), kargs, LDS_BYTES, stream);
#else
    hipFuncSetAttribute((const void*)fwd_megakernel<0, 1>, hipFuncAttributeMaxDynamicSharedMemorySize, LDS_BYTES); hipFuncSetAttribute((const void*)fwd_megakernel<1, 2>, hipFuncAttributeMaxDynamicSharedMemorySize, LDS_BYTES);
    hipFuncSetAttribute((const void*)fwd_megakernel<2, 3>, hipFuncAttributeMaxDynamicSharedMemorySize, LDS_BYTES); hipFuncSetAttribute((const void*)fwd_megakernel<3, 4>, hipFuncAttributeMaxDynamicSharedMemorySize, LDS_BYTES);
    for (int r_ = 0; r_ < N_LAUNCHES - 3; ++r_) hipLaunchKernelGGL((fwd_megakernel<0, 1>), dim3(grid), dim3(512), LDS_BYTES, stream, a);
    hipLaunchKernelGGL((fwd_megakernel<1, 2>), dim3(grid), dim3(512), LDS_BYTES, stream, a);
    hipLaunchKernelGGL((fwd_megakernel<2, 3>), dim3(grid), dim3(512), LDS_BYTES, stream, a); hipLaunchKernelGGL((fwd_megakernel<3, 4>), dim3(grid), dim3(512), LDS_BYTES, stream, a);
    e = hipPeekAtLastError();
#endif
    if (e != hipSuccess) fprintf(stderr, "kernel_launch: cooperative launch failed: %s (grid %d)\n", hipGetErrorString(e), grid);
}
```
